# Optimizing an MI355X kernel written in HIP

```python
import math
import jax, jax.numpy as jnp
from jax import lax
import numpy as np

D_MODEL = 2048
BATCH = 1
SEQ = 8192
DEPTH = 4

CHUNK = 64
Q_BLOCK = 128
D_CONV = 1024
CONV_WIDTH = 3
N_HEADS = 8
HEAD_DIM = 64
V_DIM = 2 * HEAD_DIM
D_ATTN = N_HEADS * V_DIM
ROPE_THETA = 10000.0
EPS = 1e-6
LAMBDA_STD = 0.1
D_IN = 4 * D_CONV + 4 * D_ATTN + 2 * D_MODEL

kernel_name = "hybrid_shortconv_diffattn_block"


def rms_norm(x, g):
    xf = x.astype(jnp.float32)
    y = xf * lax.rsqrt(jnp.mean(xf * xf, axis=-1, keepdims=True) + EPS)
    return (y * g.astype(jnp.float32)).astype(x.dtype)


def split_columns(p, sizes):
    outs, start = [], 0
    for s in sizes:
        outs.append(p[..., start:start + s])
        start += s
    return outs


def rope(x, pos):
    half = HEAD_DIM // 2
    inv = ROPE_THETA ** (-jnp.arange(half, dtype=jnp.float32) / half)
    ang = pos.astype(jnp.float32)[:, None] * inv[None, :]
    cos = jnp.cos(ang)[None, :, None, None, :]
    sin = jnp.sin(ang)[None, :, None, None, :]
    xf = x.astype(jnp.float32)
    x1, x2 = xf[..., :half], xf[..., half:]
    out = jnp.concatenate([x1 * cos - x2 * sin, x2 * cos + x1 * sin], axis=-1)
    return out.astype(x.dtype)


def short_conv_branch(u, b_gate, c_gate, z, conv_w, w_out):
    v = c_gate * u
    y = lax.conv_general_dilated(
        v, conv_w[:, None, :], window_strides=(1,),
        padding=((CONV_WIDTH - 1, 0),),
        dimension_numbers=("NWC", "WIO", "NWC"),
        feature_group_count=D_CONV)
    return (b_gate * y * jax.nn.silu(z)) @ w_out


def diff_attention(q, k, v, lam, lambda_init, subln_g):
    bsz, seq = q.shape[0], q.shape[1]
    scale = HEAD_DIM ** -0.5
    k_chunk = jnp.arange(seq) // CHUNK

    def block(i):
        start = i * Q_BLOCK
        qb = lax.dynamic_slice_in_dim(q, start, Q_BLOCK, axis=1)
        s = jnp.einsum("bqhcd,bkhcd->bhcqk", qb, k,
                       preferred_element_type=jnp.float32) * scale
        q_chunk = (start + jnp.arange(Q_BLOCK)) // CHUNK
        mask = k_chunk[None, :] <= q_chunk[:, None]
        s = jnp.where(mask, s, -jnp.inf)
        p = jax.nn.softmax(s, axis=-1)
        a = p[:, :, 0] - lam * p[:, :, 1]
        return jnp.einsum("bhqk,bkhe->bqhe", a.astype(v.dtype), v)

    out = lax.map(block, jnp.arange(seq // Q_BLOCK))
    out = jnp.moveaxis(out, 0, 1).reshape(bsz, seq, N_HEADS, V_DIM)
    out = rms_norm(out, subln_g) * (1.0 - lambda_init)
    return out.reshape(bsz, seq, D_ATTN)


def setup_inputs(seed: int = 0) -> dict:
    key = jax.random.key(seed)
    ks = jax.random.split(key, 18)
    f32 = jnp.float32
    n = lambda k, shape, s: jax.random.normal(k, shape, f32) * s
    return {
        "x": n(ks[0], (BATCH, SEQ, D_MODEL), 1.0),
        "c": n(ks[1], (BATCH, D_MODEL), 1.0),
        "ada_w": n(ks[2], (DEPTH, D_MODEL, 3 * D_MODEL), D_MODEL ** -0.5),
        "ada_b": n(ks[3], (DEPTH, 3 * D_MODEL), 0.01),
        "norm_g": 1.0 + n(ks[4], (DEPTH, D_MODEL), 0.01),
        "w_in": n(ks[5], (DEPTH, D_MODEL, D_IN), D_MODEL ** -0.5),
        "conv_w": n(ks[6], (DEPTH, CONV_WIDTH, D_CONV), CONV_WIDTH ** -0.5),
        "w_conv_out": n(ks[7], (DEPTH, D_CONV, D_MODEL), D_CONV ** -0.5),
        "q_norm_g": 1.0 + n(ks[8], (DEPTH, HEAD_DIM), 0.01),
        "k_norm_g": 1.0 + n(ks[9], (DEPTH, HEAD_DIM), 0.01),
        "lam_q1": n(ks[10], (DEPTH, HEAD_DIM), LAMBDA_STD),
        "lam_k1": n(ks[11], (DEPTH, HEAD_DIM), LAMBDA_STD),
        "lam_q2": n(ks[12], (DEPTH, HEAD_DIM), LAMBDA_STD),
        "lam_k2": n(ks[13], (DEPTH, HEAD_DIM), LAMBDA_STD),
        "subln_g": 1.0 + n(ks[14], (DEPTH, V_DIM), 0.01),
        "w_attn_out": n(ks[15], (DEPTH, D_ATTN, D_MODEL), D_ATTN ** -0.5),
        "w_o": n(ks[16], (DEPTH, D_MODEL, D_MODEL), D_MODEL ** -0.5),
    }


def reference(x, c, ada_w, ada_b, norm_g, w_in, conv_w, w_conv_out, q_norm_g, k_norm_g,
              lam_q1, lam_k1, lam_q2, lam_k2, subln_g, w_attn_out, w_o):
    bsz, seq = x.shape[0], x.shape[1]
    pos = jnp.arange(seq)
    c_act = jax.nn.silu(c)
    sizes = [D_CONV] * 4 + [D_ATTN] * 4 + [D_MODEL] * 2
    for l in range(DEPTH):
        mod = c_act @ ada_w[l] + ada_b[l]
        shift, scale, gate = jnp.split(mod, 3, axis=-1)
        h = rms_norm(x, norm_g[l]) * (1.0 + scale[:, None, :]) + shift[:, None, :]

        proj = h @ w_in[l]
        u, bg, cg, za, q, k, v, zb, ga, gb = split_columns(proj, sizes)

        y_conv = short_conv_branch(u, bg, cg, za, conv_w[l], w_conv_out[l])

        q = rope(rms_norm(q.reshape(bsz, seq, N_HEADS, 2, HEAD_DIM), q_norm_g[l]), pos)
        k = rope(rms_norm(k.reshape(bsz, seq, N_HEADS, 2, HEAD_DIM), k_norm_g[l]), pos)
        v = v.reshape(bsz, seq, N_HEADS, V_DIM)
        lambda_init = 0.8 - 0.6 * math.exp(-0.3 * l)
        lam = (jnp.exp(jnp.sum(lam_q1[l].astype(jnp.float32) * lam_k1[l].astype(jnp.float32)))
               - jnp.exp(jnp.sum(lam_q2[l].astype(jnp.float32) * lam_k2[l].astype(jnp.float32)))
               + lambda_init)
        o_attn = diff_attention(q, k, v, lam, lambda_init, subln_g[l])
        y_attn = (o_attn * jax.nn.silu(zb)) @ w_attn_out[l]

        merged = jax.nn.sigmoid(ga) * y_conv + jax.nn.sigmoid(gb) * y_attn
        x = x + gate[:, None, :] * (merged @ w_o[l])
    return x
```

```cpp
#include <hip/hip_runtime.h>
#include <hip/hip_cooperative_groups.h>
#include <cstdio>
#include <cstdint>
namespace cg = cooperative_groups;
#ifndef MK_MULTI
#define MK_MULTI 0
#endif
namespace pg8 {
#define PG8_LAS __attribute__((address_space(3)))
typedef unsigned short bf16_t;
typedef short bf16x8 __attribute__((ext_vector_type(8)));
typedef float f32x4 __attribute__((ext_vector_type(4)));
typedef unsigned u32x4 __attribute__((ext_vector_type(4)));
constexpr int BM = 256, BK = 64, HALF = 128, HTB = HALF * BK * 2  , STAGE_BYTES = 8 * HTB, NXCD = 8, WGM = 8;

__host__ __device__ __forceinline__ int lds_byte(int r, int c) { const int st = (r >> 4) * 2 + (c >> 5), rr = r & 15, cc = c & 31, ob = rr * 64 + cc * 2; return st * 1024 + (ob ^ (((ob >> 9) & 1) << 5)); }
__host__ __device__ __forceinline__ void stage_rc(int b, int& R, int& C) { const int st = b / 1024, sb = b % 1024, swz = sb ^ (((sb >> 9) & 1) << 5); R = (st >> 1) * 16 + swz / 64; C = (st & 1) * 32 + (swz % 64) / 2; }
__host__ __device__ __forceinline__ int perm32(int rho) { const int n = rho >> 4, i = rho & 15; return 8 * (i >> 2) + 4 * n + (i & 3); }

struct Unit { int pm, pn; };
struct Gemm { const bf16_t* A; const bf16_t* Bt; int M, N, K; };

struct StaticOrder {
    int nM, nN, nwg, G, c;
    __host__ __device__ void init(int M, int N, int G_, int c_) { nM = M / BM; nN = N / BM; nwg = nM * nN; G = G_; c = c_; }
    __host__ __device__ bool next(int i, Unit& u) const {
        const long L = (long)i * G + c; if (L >= nwg) return false;
        int wgid = (int)L; { const int q = nwg / NXCD, r = nwg % NXCD, xcd = wgid % NXCD, off = wgid / NXCD; wgid = (xcd < r ? xcd * (q + 1) : r * (q + 1) + (xcd - r) * q) + off; }
        const int nig = WGM * nN, gid = wgid / nig, fm = gid * WGM, gsz = (nM - fm) < WGM ? (nM - fm) : WGM;
        u.pm = fm + ((wgid % nig) % gsz); u.pn = (wgid % nig) / gsz; return true;
    }
    __device__ __forceinline__ void a_ready(const Unit&) const {}
    __device__ __forceinline__ void done(const Unit&) const {}
};

__device__ __forceinline__ unsigned cvt_pk_bf16(float lo, float hi) { unsigned r; asm volatile("v_cvt_pk_bf16_f32 %0, %1, %2" : "=v"(r) : "v"(lo), "v"(hi)); return r; }
__device__ __forceinline__ float bf_lo(unsigned w) { return __uint_as_float(w << 16); }
__device__ __forceinline__ float bf_hi(unsigned w) { return __uint_as_float(w & 0xffff0000u); }
__device__ __forceinline__ float fexp2(float x) { return __builtin_amdgcn_exp2f(x); }
__device__ __forceinline__ float frcp(float x) { return __builtin_amdgcn_rcpf(x); }
constexpr float L2E = 1.4426950408889634f;
__device__ __forceinline__ float silu_f(float x) { return x * frcp(1.0f + fexp2(-x * L2E)); }
__device__ __forceinline__ u32x4 pack8(const f32x4 a, const f32x4 b) { u32x4 w; w.x = cvt_pk_bf16(a[0], a[1]); w.y = cvt_pk_bf16(a[2], a[3]); w.z = cvt_pk_bf16(b[0], b[1]); w.w = cvt_pk_bf16(b[2], b[3]); return w; }

struct InProjEpi {
    static constexpr bool PERM = true, AFTER_DRAIN = false;
    bf16_t *Q, *Kb, *V, *VG, *GG, *ZB, *R, *SB; const float* qg; const float* kg; const float* rope; float qscale;
    __device__ __forceinline__ void operator()(const f32x4 (&acc)[2][2][4][2], const Unit& u, int wr, int wc, int fr, int fq) const {
        const int pn = u.pn; const int row0 = u.pm * BM + wr * 64 + fr;
        if (pn < 16) {
            const bool bz = pn >= 8; const int jt = pn & 7; bf16_t* out = bz ? GG : VG; const int col = jt * 128 + wc * 32 + 8 * fq;
#pragma unroll
            for (int ai = 0; ai < 2; ++ai)
#pragma unroll
                for (int m = 0; m < 4; ++m) { const int row = row0 + ai * HALF + m * 16;
                    f32x4 a0 = acc[ai][0][m][0], a1 = acc[ai][0][m][1], b0 = acc[ai][1][m][0], b1 = acc[ai][1][m][1];
                    if (bz) {
#pragma unroll
                        for (int j = 0; j < 4; ++j) { b0[j] = silu_f(b0[j]); b1[j] = silu_f(b1[j]); } }
                    *(u32x4*)(out + (size_t)row * 1024 + col) = pack8(a0 * b0, a1 * b1); }
        } else if (pn < 24) {
            const bool isk = pn >= 20; const int jt = (pn - 16) & 3; const float* gw = isk ? kg : qg; bf16_t* out = isk ? Kb : Q;
            const int d0 = 8 * fq; const int colbase = 64 * (4 * jt + wc) + d0; const float sc = isk ? 1.0f : qscale;
            const f32x4 gl0 = *(const f32x4*)(gw + d0), gl1 = *(const f32x4*)(gw + d0 + 4), gh0 = *(const f32x4*)(gw + 32 + d0), gh1 = *(const f32x4*)(gw + 32 + d0 + 4);
#pragma unroll
            for (int ai = 0; ai < 2; ++ai)
#pragma unroll
                for (int m = 0; m < 4; ++m) { const int row = row0 + ai * HALF + m * 16;
                    const f32x4 xl0 = acc[ai][0][m][0], xl1 = acc[ai][0][m][1], xh0 = acc[ai][1][m][0], xh1 = acc[ai][1][m][1];
                    float ss = 0.f;
#pragma unroll
                    for (int j = 0; j < 4; ++j) ss += xl0[j] * xl0[j] + xl1[j] * xl1[j] + xh0[j] * xh0[j] + xh1[j] * xh1[j];
                    ss += __shfl_xor(ss, 16); ss += __shfl_xor(ss, 32);
                    const float rn = __builtin_amdgcn_rsqf(ss * (1.0f / 64.0f) + 1e-6f);
                    const f32x4* rp = (const f32x4*)(rope + ((size_t)row * 32 + d0) * 2);
                    const f32x4 c0 = rp[0], c1 = rp[1], c2 = rp[2], c3 = rp[3];
                    const f32x4 al0 = xl0 * rn * gl0, al1 = xl1 * rn * gl1, ah0 = xh0 * rn * gh0, ah1 = xh1 * rn * gh1;
                    f32x4 ol0, ol1, oh0, oh1;
                    ol0[0] = al0[0] * c0[0] - ah0[0] * c0[1]; oh0[0] = ah0[0] * c0[0] + al0[0] * c0[1];
                    ol0[1] = al0[1] * c0[2] - ah0[1] * c0[3]; oh0[1] = ah0[1] * c0[2] + al0[1] * c0[3];
                    ol0[2] = al0[2] * c1[0] - ah0[2] * c1[1]; oh0[2] = ah0[2] * c1[0] + al0[2] * c1[1];
                    ol0[3] = al0[3] * c1[2] - ah0[3] * c1[3]; oh0[3] = ah0[3] * c1[2] + al0[3] * c1[3];
                    ol1[0] = al1[0] * c2[0] - ah1[0] * c2[1]; oh1[0] = ah1[0] * c2[0] + al1[0] * c2[1];
                    ol1[1] = al1[1] * c2[2] - ah1[1] * c2[3]; oh1[1] = ah1[1] * c2[2] + al1[1] * c2[3];
                    ol1[2] = al1[2] * c3[0] - ah1[2] * c3[1]; oh1[2] = ah1[2] * c3[0] + al1[2] * c3[1];
                    ol1[3] = al1[3] * c3[2] - ah1[3] * c3[3]; oh1[3] = ah1[3] * c3[2] + al1[3] * c3[3];
                    *(u32x4*)(out + (size_t)row * 1024 + colbase) = pack8(ol0 * sc, ol1 * sc);
                    *(u32x4*)(out + (size_t)row * 1024 + colbase + 32) = pack8(oh0 * sc, oh1 * sc); }
        } else if (pn < 32) {
            const bool zb = pn >= 28; const int jt = (pn - 24) & 3; bf16_t* out = zb ? ZB : V; const int col = jt * 256 + wc * 32 + 8 * fq;
#pragma unroll
            for (int ai = 0; ai < 2; ++ai)
#pragma unroll
                for (int m = 0; m < 4; ++m) { const int row = row0 + ai * HALF + m * 16;
#pragma unroll
                    for (int bj = 0; bj < 2; ++bj) { f32x4 a0 = acc[ai][bj][m][0], a1 = acc[ai][bj][m][1];
                        if (zb) {
#pragma unroll
                            for (int j = 0; j < 4; ++j) { a0[j] = silu_f(a0[j]); a1[j] = silu_f(a1[j]); } }
                        *(u32x4*)(out + (size_t)row * 1024 + col + bj * HALF) = pack8(a0, a1); } }
        } else {
            const int jt = pn - 32; const int col = jt * 128 + wc * 32 + 8 * fq;
#pragma unroll
            for (int ai = 0; ai < 2; ++ai)
#pragma unroll
                for (int m = 0; m < 4; ++m) { const int row = row0 + ai * HALF + m * 16;
                    f32x4 r0, r1, s0, s1;
#pragma unroll
                    for (int n = 0; n < 2; ++n)
#pragma unroll
                        for (int j = 0; j < 4; ++j) { const float a = acc[ai][0][m][n][j], b = acc[ai][1][m][n][j];
                            const float ea = fexp2(-a * L2E), eb = fexp2(-b * L2E); const float sb = frcp(1.0f + eb), r = frcp(1.0f + ea);
                            if (n == 0) { r0[j] = r; s0[j] = sb; } else { r1[j] = r; s1[j] = sb; } }
                    *(u32x4*)(R + (size_t)row * 2048 + col) = pack8(r0, r1);
                    *(u32x4*)(SB + (size_t)row * 2048 + col) = pack8(s0, s1); }
        }
    }
};
struct Merge1Epi {
    static constexpr bool PERM = true, AFTER_DRAIN = false;
    const bf16_t* SA; float* T;
    __device__ __forceinline__ void operator()(const f32x4 (&acc)[2][2][4][2], const Unit& u, int wr, int wc, int fr, int fq) const {
        const int row0 = u.pm * BM + wr * 64 + fr, col0 = u.pn * BM + wc * 32 + 8 * fq;
#pragma unroll
        for (int ai = 0; ai < 2; ++ai)
#pragma unroll
            for (int m = 0; m < 4; ++m) {
#pragma unroll
                for (int bj = 0; bj < 2; ++bj) { const size_t off = (size_t)(row0 + ai * HALF + m * 16) * 2048 + col0 + bj * HALF; const u32x4 w = *(const u32x4*)(SA + off);
                    *(f32x4*)(T + off) = acc[ai][bj][m][0] * (f32x4){bf_lo(w.x), bf_hi(w.x), bf_lo(w.y), bf_hi(w.y)}; *(f32x4*)(T + off + 4) = acc[ai][bj][m][1] * (f32x4){bf_lo(w.z), bf_hi(w.z), bf_lo(w.w), bf_hi(w.w)}; }
                if (m & 1) asm volatile("" ::: "memory"); }
    }
};
struct Merge2Epi {
    static constexpr bool PERM = true, AFTER_DRAIN = false;
    const bf16_t* SB; const float* T; bf16_t* O;
    __device__ __forceinline__ void operator()(const f32x4 (&acc)[2][2][4][2], const Unit& u, int wr, int wc, int fr, int fq) const {
        const int row0 = u.pm * BM + wr * 64 + fr, col0 = u.pn * BM + wc * 32 + 8 * fq;
#pragma unroll
        for (int ai = 0; ai < 2; ++ai)
#pragma unroll
            for (int m = 0; m < 4; ++m) {
#pragma unroll
                for (int bj = 0; bj < 2; ++bj) { const size_t off = (size_t)(row0 + ai * HALF + m * 16) * 2048 + col0 + bj * HALF; const u32x4 w = *(const u32x4*)(SB + off);
                    const f32x4 t0 = *(const f32x4*)(T + off), t1 = *(const f32x4*)(T + off + 4);
                    const f32x4 a0 = t0 + acc[ai][bj][m][0] * (f32x4){bf_lo(w.x), bf_hi(w.x), bf_lo(w.y), bf_hi(w.y)}, a1 = t1 + acc[ai][bj][m][1] * (f32x4){bf_lo(w.z), bf_hi(w.z), bf_lo(w.w), bf_hi(w.w)};
                    *(u32x4*)(O + off) = pack8(a0, a1); }
                if (m & 1) asm volatile("" ::: "memory"); }
    }
};
struct ResEpi {
    static constexpr bool PERM = false, AFTER_DRAIN = false;
    const float* xin; float* xout; const float* gate;
    __device__ __forceinline__ void operator()(const f32x4 (&acc)[2][2][4][2], const Unit& u, int wr, int wc, int fr, int fq) const {
        const int row0 = u.pm * BM + wr * 64 + fr, col0 = u.pn * BM + wc * 32 + 4 * fq;
        f32x4 gv[2][2];
#pragma unroll
        for (int bj = 0; bj < 2; ++bj)
#pragma unroll
            for (int n = 0; n < 2; ++n) gv[bj][n] = *(const f32x4*)(gate + col0 + bj * HALF + n * 16);
#pragma unroll
        for (int ai = 0; ai < 2; ++ai)
#pragma unroll
            for (int m = 0; m < 4; ++m) { const size_t off = (size_t)(row0 + ai * HALF + m * 16) * 2048 + col0;
#pragma unroll
                for (int bj = 0; bj < 2; ++bj)
#pragma unroll
                    for (int n = 0; n < 2; ++n) { const f32x4 xi = *(const f32x4*)(xin + off + bj * HALF + n * 16);
                        *(f32x4*)(xout + off + bj * HALF + n * 16) = xi + gv[bj][n] * acc[ai][bj][m][n]; } }
    }
};
template <class Epi, class Sched, bool ALIGN_EPI = false, bool SP2 = false>
__device__ __forceinline__ void gemm_phase(PG8_LAS unsigned char* lds, const Gemm g, const Sched& S, const Epi& E) {
    int tid_ = threadIdx.x; asm volatile("" : "+v"(tid_));
    const int tid = tid_, wid = __builtin_amdgcn_readfirstlane(tid >> 6), lane = tid & 63, wr = wid >> 2, wc = wid & 3, fr = lane & 15, fq = lane >> 4;
    const int K = g.K, nt = K / BK;
    unsigned voffA[2], voffB[2];
#pragma unroll
    for (int i = 0; i < 2; ++i) { int R, C; stage_rc(tid * 16 + i * 8192, R, C); const int Rb = Epi::PERM ? ((R & ~31) + perm32(R & 31)) : R;
        voffA[i] = (unsigned)(R * K + C) * 2u; voffB[i] = (unsigned)(Rb * K + C) * 2u; }
    const size_t kstep = (size_t)(BK * 2);
    const size_t hstep = (size_t)HALF * K * 2;
    const size_t tstep = 2 * hstep;
    const unsigned ldsw = (unsigned)wid * 1024u;
    const int aoff = lds_byte(wr * 64 + fr, fq * 8), boff = lds_byte(wc * 32 + fr, fq * 8);
#define PG8_SA(b, h) (((b) * 2 + (h)) * HTB)
#define PG8_SB(b, h) ((4 + (b) * 2 + (h)) * HTB)
#define PG8_STAGE(bufoff, gbase, voff) do { _Pragma("unroll") for (int _i = 0; _i < 2; ++_i) \
        __builtin_amdgcn_global_load_lds((const unsigned*)((const char*)(gbase) + (voff)[_i]), (PG8_LAS unsigned*)(lds + (bufoff) + ldsw + _i * 8192), 16, 0, 0); } while (0)
#define PG8_LDA(dst, b, h) do { _Pragma("unroll") for (int m = 0; m < 4; ++m) _Pragma("unroll") for (int k = 0; k < 2; ++k) dst[m][k] = *(const PG8_LAS bf16x8*)(lds + PG8_SA(b, h) + aoff + m * 2048 + k * 1024); } while (0)
#define PG8_LDB(dst, b, h) do { _Pragma("unroll") for (int n = 0; n < 2; ++n) _Pragma("unroll") for (int k = 0; k < 2; ++k) dst[n][k] = *(const PG8_LAS bf16x8*)(lds + PG8_SB(b, h) + boff + n * 2048 + k * 1024); } while (0)
#define PG8_MMA(ai, bj, At, Bt) do { __builtin_amdgcn_s_setprio(1); _Pragma("unroll") for (int m = 0; m < 4; ++m) _Pragma("unroll") for (int n = 0; n < 2; ++n) _Pragma("unroll") for (int k = 0; k < 2; ++k) \
        acc[ai][bj][m][n] = __builtin_amdgcn_mfma_f32_16x16x32_bf16(Bt[n][k], At[m][k], acc[ai][bj][m][n], 0, 0, 0); __builtin_amdgcn_s_setprio(0); } while (0)
#define PG8_WAIT_V(n) asm volatile("s_waitcnt vmcnt(" #n ")" ::: "memory")
#define PG8_WAIT_L(n) asm volatile("s_waitcnt lgkmcnt(" #n ")" ::: "memory")
#define PG8_BAR __builtin_amdgcn_s_barrier()
#define PG8_SCHED __builtin_amdgcn_sched_barrier(0)
    Unit cur, nxt; int ui = 0;
    if (!S.next(0, cur)) return;
    f32x4 acc[2][2][4][2];
#pragma unroll
    for (int a = 0; a < 2; ++a)
#pragma unroll
        for (int b = 0; b < 2; ++b)
#pragma unroll
            for (int m = 0; m < 4; ++m)
#pragma unroll
                for (int n = 0; n < 2; ++n) acc[a][b][m][n] = (f32x4){0.f, 0.f, 0.f, 0.f};
    bf16x8 At[4][2], B0[2][2], B1[2][2];
    const char* cA = (const char*)g.A + (size_t)cur.pm * tstep; const char* cB = (const char*)g.Bt + (size_t)cur.pn * tstep;
    S.a_ready(cur);
    if constexpr (SP2) {
        PG8_STAGE(PG8_SB(0, 0), cB, voffB); PG8_STAGE(PG8_SB(0, 1), cB + hstep, voffB); PG8_STAGE(PG8_SA(0, 0), cA, voffA); PG8_STAGE(PG8_SA(0, 1), cA + hstep, voffA);
        if (wr == 1) PG8_BAR;
        PG8_WAIT_V(2); PG8_BAR;
        PG8_STAGE(PG8_SB(1, 0), cB + kstep, voffB); PG8_STAGE(PG8_SA(1, 0), cA + kstep, voffA); PG8_STAGE(PG8_SB(1, 1), cB + hstep + kstep, voffB);
        PG8_WAIT_V(6); PG8_BAR;
    } else {
        PG8_STAGE(PG8_SB(0, 0), cB, voffB); PG8_STAGE(PG8_SA(0, 0), cA, voffA); PG8_STAGE(PG8_SB(0, 1), cB + hstep, voffB); PG8_STAGE(PG8_SA(0, 1), cA + hstep, voffA);
        if (wr == 1) PG8_BAR;
        PG8_WAIT_V(4); PG8_BAR;
        PG8_STAGE(PG8_SB(1, 0), cB + kstep, voffB); PG8_STAGE(PG8_SA(1, 0), cA + kstep, voffA); PG8_STAGE(PG8_SB(1, 1), cB + hstep + kstep, voffB);
        PG8_WAIT_V(6); PG8_BAR;
    }
    for (;;) {
        const bool has_next = S.next(ui + 1, nxt);
        const char* nA = has_next ? (const char*)g.A + (size_t)nxt.pm * tstep : cA; const char* nB = has_next ? (const char*)g.Bt + (size_t)nxt.pn * tstep : cB;
        for (int t = 0; t < nt; t += 2) {
            const bool last = (t == nt - 2);
            const char* a1 = cA + (size_t)(t + 1) * kstep;
            const char* a2 = last ? nA : cA + (size_t)(t + 2) * kstep; const char* b2 = last ? nB : cB + (size_t)(t + 2) * kstep;
            const char* a3 = a2 + kstep; const char* b3 = b2 + kstep;
            if (last && has_next) S.a_ready(nxt);
            if constexpr (SP2) {
            PG8_LDB(B0, 0, 0); PG8_LDB(B1, 0, 1); PG8_SCHED; PG8_LDA(At, 0, 0); PG8_STAGE(PG8_SA(1, 1), a1 + hstep, voffA);
            PG8_WAIT_V(8); PG8_WAIT_L(0); PG8_BAR; PG8_MMA(0, 0, At, B0); PG8_MMA(0, 1, At, B1); PG8_BAR; PG8_SCHED;
            PG8_LDA(At, 0, 1); PG8_STAGE(PG8_SB(0, 0), b2, voffB); PG8_STAGE(PG8_SB(0, 1), b2 + hstep, voffB); PG8_STAGE(PG8_SA(0, 0), a2, voffA);
            PG8_WAIT_V(8); PG8_WAIT_L(0); PG8_BAR; PG8_MMA(1, 0, At, B0); PG8_MMA(1, 1, At, B1); PG8_BAR; PG8_SCHED;
            PG8_LDB(B0, 1, 0); PG8_LDB(B1, 1, 1); PG8_SCHED; PG8_LDA(At, 1, 0); PG8_STAGE(PG8_SA(0, 1), a2 + hstep, voffA);
            PG8_WAIT_V(8); PG8_WAIT_L(0); PG8_BAR; PG8_MMA(0, 0, At, B0); PG8_MMA(0, 1, At, B1); PG8_BAR; PG8_SCHED;
            PG8_LDA(At, 1, 1); PG8_STAGE(PG8_SB(1, 0), b3, voffB); PG8_STAGE(PG8_SB(1, 1), b3 + hstep, voffB); PG8_STAGE(PG8_SA(1, 0), a3, voffA);
            PG8_WAIT_V(8); PG8_WAIT_L(0); PG8_BAR; PG8_MMA(1, 0, At, B0); PG8_MMA(1, 1, At, B1); PG8_BAR; PG8_SCHED;
            } else {
            PG8_LDB(B0, 0, 0); PG8_SCHED; PG8_LDA(At, 0, 0); PG8_STAGE(PG8_SA(1, 1), a1 + hstep, voffA);
            PG8_WAIT_L(8); PG8_BAR; PG8_WAIT_L(0); PG8_MMA(0, 0, At, B0); PG8_BAR; PG8_SCHED;
            PG8_LDB(B1, 0, 1); PG8_STAGE(PG8_SB(0, 0), b2, voffB);
            PG8_BAR; PG8_WAIT_L(0); PG8_MMA(0, 1, At, B1); PG8_BAR;
            PG8_LDA(At, 0, 1); PG8_STAGE(PG8_SA(0, 0), a2, voffA);
            PG8_BAR; PG8_WAIT_L(0); PG8_MMA(1, 0, At, B0); PG8_BAR; PG8_SCHED;
            PG8_STAGE(PG8_SB(0, 1), b2 + hstep, voffB);
            PG8_WAIT_V(6); PG8_BAR; PG8_MMA(1, 1, At, B1); PG8_BAR;
            PG8_LDB(B0, 1, 0); PG8_SCHED; PG8_LDA(At, 1, 0); PG8_STAGE(PG8_SA(0, 1), a2 + hstep, voffA);
            PG8_WAIT_L(8); PG8_BAR; PG8_WAIT_L(0); PG8_MMA(0, 0, At, B0); PG8_BAR; PG8_SCHED;
            PG8_LDB(B1, 1, 1); PG8_STAGE(PG8_SB(1, 0), b3, voffB);
            PG8_BAR; PG8_WAIT_L(0); PG8_MMA(0, 1, At, B1); PG8_BAR;
            PG8_LDA(At, 1, 1); PG8_STAGE(PG8_SA(1, 0), a3, voffA);
            PG8_BAR; PG8_WAIT_L(0); PG8_MMA(1, 0, At, B0); PG8_BAR; PG8_SCHED;
            PG8_STAGE(PG8_SB(1, 1), b3 + hstep, voffB);
            PG8_WAIT_V(6); PG8_BAR; PG8_MMA(1, 1, At, B1); PG8_BAR;
            }
        }
        if constexpr (ALIGN_EPI) { if (wr == 0) PG8_BAR; }
        if constexpr (!Epi::AFTER_DRAIN) { E(acc, cur, wr, wc, fr, fq); S.done(cur); }
        if (!has_next) break;
#pragma unroll
        for (int a = 0; a < 2; ++a)
#pragma unroll
            for (int b = 0; b < 2; ++b)
#pragma unroll
                for (int m = 0; m < 4; ++m)
#pragma unroll
                    for (int n = 0; n < 2; ++n) acc[a][b][m][n] = (f32x4){0.f, 0.f, 0.f, 0.f};
        cur = nxt; cA = nA; cB = nB; ++ui;
        if constexpr (ALIGN_EPI) { if (wr == 1) PG8_BAR; }
    }
    PG8_WAIT_V(0);
    if constexpr (!ALIGN_EPI) { if (wr == 0) PG8_BAR; }
    PG8_BAR;
    if constexpr (Epi::AFTER_DRAIN) { E.fused(acc, cur, wr, wc, fr, fq, lds, wid, lane); S.done(cur); }
#undef PG8_SA
#undef PG8_SB
#undef PG8_STAGE
#undef PG8_LDA
#undef PG8_LDB
#undef PG8_MMA
#undef PG8_WAIT_V
#undef PG8_WAIT_L
#undef PG8_BAR
#undef PG8_SCHED
}
}
constexpr int S_ = 8192, D_ = 2048, DIN = 12288, DEPTH = 4;
constexpr size_t MiB = 1u << 20;
constexpr size_t WS_MOD = 0, WS_ROPE = 1 * MiB, WS_WIN = 4 * MiB, WS_WOUT = 196 * MiB, WS_WO = 228 * MiB, WS_H = 260 * MiB, WS_Q = 292 * MiB, WS_K = 308 * MiB, WS_V = 324 * MiB,
                 WS_VG = 340 * MiB, WS_GG = 356 * MiB, WS_ZB = 372 * MiB, WS_R = 388 * MiB, WS_SB = 420 * MiB, WS_YCAT = 452 * MiB, WS_MG = 484 * MiB, WS_X = 516 * MiB, WS_T = 580 * MiB, WS_END = 644 * MiB;
constexpr int LDS_BYTES = 147456;
#define LAS __attribute__((address_space(3)))
typedef unsigned short bf16;
typedef unsigned v4u __attribute__((ext_vector_type(4)));
typedef unsigned v2u __attribute__((ext_vector_type(2)));
typedef float f32x4 __attribute__((ext_vector_type(4)));
typedef float f32x16 __attribute__((ext_vector_type(16)));
typedef short bf16x8 __attribute__((ext_vector_type(8)));
typedef short s16x4 __attribute__((ext_vector_type(4)));
using pg8::cvt_pk_bf16; using pg8::bf_lo; using pg8::bf_hi; using pg8::fexp2; using pg8::frcp; using pg8::L2E;

struct Args { const float* in[17]; float* out; unsigned char* ws; int ph_lo, ph_hi; };

__device__ __forceinline__ float wave_sum(float v) {
#pragma unroll
    for (int o = 1; o < 64; o <<= 1) v += __shfl_xor(v, o);
    return v;
}
__device__ __forceinline__ int map_in(int n0) {
    if (n0 < 4096) { const int seg = n0 >> 10, ch = n0 & 1023; const int tile = ((seg & 1) ? 8 : 0) + (ch >> 7); return tile * 256 + ((seg >> 1) ? 128 : 0) + (ch & 127); }
    if (n0 < 6144) { const int isk = n0 >= 5120, e = n0 - (isk ? 5120 : 4096), g = e >> 6, d = e & 63; return (16 + 4 * isk + (g >> 2)) * 256 + 128 * (d >> 5) + 32 * (g & 3) + (d & 31); }
    if (n0 < 8192) return n0;
    { const int isb = n0 >= 10240, j = n0 - (isb ? 10240 : 8192); return (32 + (j >> 7)) * 256 + 128 * isb + (j & 127); }
}
__device__ __forceinline__ void transpose_item(const float* W, int N, bf16* WT, int ldd, int koff, int k0, int n0, int drow0, LAS float* scr, int lane) {
#pragma unroll 8
    for (int i = 0; i < 32; ++i) { const int kk = 2 * i + (lane >> 5); scr[kk * 33 + (lane & 31)] = W[(size_t)(k0 + kk) * N + n0 + (lane & 31)]; }
    asm volatile("s_waitcnt lgkmcnt(0)" ::: "memory");
    const int c = lane & 7;
#pragma unroll
    for (int j = 0; j < 4; ++j) { const int n = (lane >> 3) + 8 * j; const LAS float* s = scr + (8 * c) * 33 + n;
        v4u o; o.x = cvt_pk_bf16(s[0 * 33], s[1 * 33]); o.y = cvt_pk_bf16(s[2 * 33], s[3 * 33]); o.z = cvt_pk_bf16(s[4 * 33], s[5 * 33]); o.w = cvt_pk_bf16(s[6 * 33], s[7 * 33]);
        *(v4u*)(WT + (size_t)(drow0 + n) * ldd + koff + k0 + 8 * c) = o; }
    asm volatile("s_waitcnt lgkmcnt(0)" ::: "memory");
}
__device__ __forceinline__ void prologue(const Args& a, LAS unsigned char* lds, int tid, int lane, int wave) {
    unsigned char* ws = a.ws;
    if (blockIdx.x < 192 || gridDim.x < 192) {
        LAS float* cact = (LAS float*)lds; LAS float* red = (LAS float*)(lds + 8192);
        for (int i = tid; i < D_; i += 512) { const float v = a.in[1][i]; cact[i] = pg8::silu_f(v); }
        __syncthreads();
        for (int cgi = blockIdx.x; cgi < 192; cgi += gridDim.x) {
            const int l = cgi / 48, col0 = (cgi % 48) * 128 + 2 * lane;
            const float* w = a.in[2] + (size_t)l * D_ * 6144 + col0; float s0 = 0.f, s1 = 0.f;
#pragma unroll 8
            for (int k = wave * 256; k < wave * 256 + 256; ++k) { const float2 v = *(const float2*)(w + (size_t)k * 6144); const float cv = cact[k]; s0 += cv * v.x; s1 += cv * v.y; }
            red[wave * 128 + 2 * lane] = s0; red[wave * 128 + 2 * lane + 1] = s1;
            __syncthreads();
            if (tid < 128) { float s = a.in[3][l * 6144 + (cgi % 48) * 128 + tid];
#pragma unroll
                for (int w8 = 0; w8 < 8; ++w8) s += red[w8 * 128 + tid];
                ((float*)(ws + WS_MOD))[l * 6144 + (cgi % 48) * 128 + tid] = s; }
            __syncthreads();
        }
    }
    for (int e = blockIdx.x * 512 + tid; e < S_ * 32; e += gridDim.x * 512) {
        const int pos = e >> 5, i = e & 31; const float inv = exp2f(-(float)i * (13.287712379549449f / 32.0f)); const float ang = (float)pos * inv;
        const double rev = (double)ang * 0.15915494309189535; const float fr = (float)(rev - floor(rev));
        ((float2*)(ws + WS_ROPE))[e] = make_float2(__builtin_amdgcn_cosf(fr), __builtin_amdgcn_sinf(fr));
    }
    LAS float* scr = (LAS float*)(lds + wave * 16384);
    const int gw = blockIdx.x * 8 + wave, NGW = gridDim.x * 8;
    constexpr int I_IN = 32 * 384, I_C = 16 * 64, I_A = 16 * 64, I_O = 32 * 64, I_L = I_IN + I_C + I_A + I_O;
    for (int it = gw; it < DEPTH * I_L; it += NGW) {
        const int l = it / I_L; int r = it % I_L;
        if (r < I_IN) { const int kb = r / 384, nb = r % 384; transpose_item(a.in[5] + (size_t)l * D_ * DIN, DIN, (bf16*)(ws + WS_WIN) + (size_t)l * DIN * D_, D_, 0, 64 * kb, 32 * nb, map_in(32 * nb), scr, lane); continue; } r -= I_IN;
        if (r < I_C) { const int kb = r / 64, nb = r % 64; transpose_item(a.in[7] + (size_t)l * 1024 * D_, D_, (bf16*)(ws + WS_WOUT) + (size_t)l * D_ * D_, 1024, 0, 64 * kb, 32 * nb, 32 * nb, scr, lane); continue; } r -= I_C;
        if (r < I_A) { const int kb = r / 64, nb = r % 64; transpose_item(a.in[15] + (size_t)l * 1024 * D_, D_, (bf16*)(ws + WS_WOUT) + (size_t)l * D_ * D_ + (size_t)D_ * 1024, 1024, 0, 64 * kb, 32 * nb, 32 * nb, scr, lane); continue; } r -= I_A;
        { const int kb = r / 64, nb = r % 64; transpose_item(a.in[16] + (size_t)l * D_ * D_, D_, (bf16*)(ws + WS_WO) + (size_t)l * D_ * D_, D_, 0, 64 * kb, 32 * nb, 32 * nb, scr, lane); }
    }
}
__device__ __forceinline__ void norm_phase(const float* x, const float* g, const float* mod, bf16* H, int lane, int wave) {
    const int gw = blockIdx.x * 8 + wave, NGW = gridDim.x * 8;
    for (int row = gw; row < S_; row += NGW) {
        const f32x4* xr = (const f32x4*)(x + (size_t)row * D_) + lane; f32x4 v[8]; float s = 0.f;
#pragma unroll
        for (int j = 0; j < 8; ++j) { v[j] = xr[64 * j]; s += (v[j].x * v[j].x + v[j].y * v[j].y) + (v[j].z * v[j].z + v[j].w * v[j].w); }
        const float rinv = __builtin_amdgcn_rsqf(wave_sum(s) * (1.0f / D_) + 1e-6f);
        v2u* o8 = (v2u*)(H + (size_t)row * D_) + lane;
#pragma unroll
        for (int j = 0; j < 8; ++j) { const int col = 4 * lane + 256 * j; const f32x4 gg = *(const f32x4*)(g + col), sh = *(const f32x4*)(mod + col), sc = *(const f32x4*)(mod + 2048 + col);
            const f32x4 y = v[j] * rinv * gg * (sc + 1.0f) + sh; v2u w; w.x = cvt_pk_bf16(y.x, y.y); w.y = cvt_pk_bf16(y.z, y.w); o8[64 * j] = w; }
    }
}
__device__ __forceinline__ void conv_phase(const bf16* VG, const bf16* GG, const float* cw, bf16* YCAT, int tid) {
    for (int item = blockIdx.x * 512 + tid; item < 1024 * 128; item += gridDim.x * 512) {
        const int cgp = item & 127, rg = item >> 7, ch = cgp * 8, t0 = rg * 8;
        float w0[8], w1[8], w2[8], v0[8], v1[8];
#pragma unroll
        for (int j = 0; j < 8; ++j) { w0[j] = cw[ch + j]; w1[j] = cw[1024 + ch + j]; w2[j] = cw[2048 + ch + j]; v0[j] = 0.f; v1[j] = 0.f; }
        if (t0 > 0) { const v4u a = *(const v4u*)(VG + (size_t)(t0 - 2) * 1024 + ch), b = *(const v4u*)(VG + (size_t)(t0 - 1) * 1024 + ch);
            v0[0] = bf_lo(a.x); v0[1] = bf_hi(a.x); v0[2] = bf_lo(a.y); v0[3] = bf_hi(a.y); v0[4] = bf_lo(a.z); v0[5] = bf_hi(a.z); v0[6] = bf_lo(a.w); v0[7] = bf_hi(a.w);
            v1[0] = bf_lo(b.x); v1[1] = bf_hi(b.x); v1[2] = bf_lo(b.y); v1[3] = bf_hi(b.y); v1[4] = bf_lo(b.z); v1[5] = bf_hi(b.z); v1[6] = bf_lo(b.w); v1[7] = bf_hi(b.w); }
#pragma unroll
        for (int i = 0; i < 8; ++i) { const v4u a = *(const v4u*)(VG + (size_t)(t0 + i) * 1024 + ch), gq = *(const v4u*)(GG + (size_t)(t0 + i) * 1024 + ch);
            float v2[8], gv[8], y[8];
            v2[0] = bf_lo(a.x); v2[1] = bf_hi(a.x); v2[2] = bf_lo(a.y); v2[3] = bf_hi(a.y); v2[4] = bf_lo(a.z); v2[5] = bf_hi(a.z); v2[6] = bf_lo(a.w); v2[7] = bf_hi(a.w);
            gv[0] = bf_lo(gq.x); gv[1] = bf_hi(gq.x); gv[2] = bf_lo(gq.y); gv[3] = bf_hi(gq.y); gv[4] = bf_lo(gq.z); gv[5] = bf_hi(gq.z); gv[6] = bf_lo(gq.w); gv[7] = bf_hi(gq.w);
#pragma unroll
            for (int j = 0; j < 8; ++j) { y[j] = gv[j] * (w0[j] * v0[j] + w1[j] * v1[j] + w2[j] * v2[j]); v0[j] = v1[j]; v1[j] = v2[j]; }
            v4u o; o.x = cvt_pk_bf16(y[0], y[1]); o.y = cvt_pk_bf16(y[2], y[3]); o.z = cvt_pk_bf16(y[4], y[5]); o.w = cvt_pk_bf16(y[6], y[7]);
            *(v4u*)(YCAT + (size_t)(t0 + i) * 1024 + ch) = o; }
    }
}
namespace att {
constexpr int KS = 144, VS = 320, KT_BYTES = 2 * 64 * KS, VT_BYTES = 64 * VS, BUF = KT_BYTES + VT_BYTES;
constexpr float THR = 8.0f;
__device__ __forceinline__ int crow(int r, int hi) { return (r & 3) + 8 * (r >> 2) + 4 * hi; }
__device__ __forceinline__ s16x4 vtr(const LAS unsigned char* p) { return __builtin_bit_cast(s16x4, __builtin_amdgcn_ds_read_tr16_b64_v4i16((LAS s16x4*)p)); }
__device__ __forceinline__ void unit(LAS unsigned char* lds, const bf16* Q, const bf16* K, const bf16* V, const bf16* ZB, bf16* YCAT, const float* subg, float lam, float oscale, int h, int qb, int tid, int lane, int w) {
    const int c = w >> 2, wq = w & 3, r32 = lane & 31, hi = lane >> 5;
    const int q0 = 128 * qb + 32 * wq, NT = 2 * qb + 2, ntw = (q0 >> 6) + 1;
    bf16x8 qf[4];
    { const bf16* qp = Q + (size_t)(q0 + r32) * 1024 + 128 * h + 64 * c + 8 * hi;
#pragma unroll
      for (int ks = 0; ks < 4; ++ks) qf[ks] = *(const bf16x8*)(qp + 16 * ks); }
    const int key_s = tid >> 4, ch_s = tid & 15;
    const bf16* kg = K + (size_t)key_s * 1024 + 128 * h + ch_s * 8; const bf16* vg = V + (size_t)key_s * 1024 + 128 * h + ch_s * 8;
    const int kdst = (ch_s >> 3) * 64 * KS + key_s * KS + (ch_s & 7) * 16, vdst = KT_BYTES + key_s * VS + ch_s * 16;
    v4u kr[2], vr[2];
#define ATT_LOAD(t) do { _Pragma("unroll") for (int i_ = 0; i_ < 2; ++i_) { kr[i_] = *(const v4u*)(kg + (size_t)(64 * (t) + 32 * i_) * 1024); vr[i_] = *(const v4u*)(vg + (size_t)(64 * (t) + 32 * i_) * 1024); } } while (0)
#define ATT_STORE(b) do { _Pragma("unroll") for (int i_ = 0; i_ < 2; ++i_) { *(LAS v4u*)(lds + (b) * BUF + kdst + 32 * i_ * KS) = kr[i_]; *(LAS v4u*)(lds + (b) * BUF + vdst + 32 * i_ * VS) = vr[i_]; } } while (0)
    ATT_LOAD(0); ATT_STORE(0);
    f32x16 o[4];
#pragma unroll
    for (int b = 0; b < 4; ++b) o[b] = f32x16{};
    float mref = -1e30f, l = 0.f;
    const int kfo = c * 64 * KS + r32 * KS + hi * 16;
    const int vfo = KT_BYTES + (4 * hi + ((lane & 15) >> 2)) * VS + (16 * ((lane >> 4) & 1) + 4 * (lane & 3)) * 2;
    for (int t = 0; t < NT; ++t) {
        __syncthreads();
        if (t + 1 < NT) ATT_LOAD(t + 1);
        if (t < ntw) {
            const LAS unsigned char* kb = lds + (t & 1) * BUF + kfo; const LAS unsigned char* vb = lds + (t & 1) * BUF + vfo;
            f32x16 p0 = f32x16{}, p1 = f32x16{};
#pragma unroll
            for (int ks = 0; ks < 4; ++ks) { const bf16x8 a0 = *(const LAS bf16x8*)(kb + ks * 32), a1 = *(const LAS bf16x8*)(kb + 32 * KS + ks * 32);
                p0 = __builtin_amdgcn_mfma_f32_32x32x16_bf16(a0, qf[ks], p0, 0, 0, 0); p1 = __builtin_amdgcn_mfma_f32_32x32x16_bf16(a1, qf[ks], p1, 0, 0, 0); }
            float rm = fmaxf(p0[0], p1[0]);
#pragma unroll
            for (int r = 1; r < 16; ++r) rm = fmaxf(rm, fmaxf(p0[r], p1[r]));
            rm = fmaxf(rm, __shfl_xor(rm, 32));
            if (__any(rm > mref + THR)) { const float mn = fmaxf(mref, rm); const float al = fexp2(mref - mn); mref = mn; l *= al;
#pragma unroll
                for (int b = 0; b < 4; ++b) o[b] *= al; }
            float ls = 0.f;
#pragma unroll
            for (int r = 0; r < 16; ++r) { p0[r] = fexp2(p0[r] - mref); p1[r] = fexp2(p1[r] - mref); ls += p0[r] + p1[r]; }
            l += ls;
            bf16x8 pw[4];
#pragma unroll
            for (int s = 0; s < 4; ++s) { v4u u_;
                if (s < 2) { u_.x = cvt_pk_bf16(p0[8 * s], p0[8 * s + 1]); u_.y = cvt_pk_bf16(p0[8 * s + 2], p0[8 * s + 3]); u_.z = cvt_pk_bf16(p0[8 * s + 4], p0[8 * s + 5]); u_.w = cvt_pk_bf16(p0[8 * s + 6], p0[8 * s + 7]); }
                else { const int s2 = s - 2; u_.x = cvt_pk_bf16(p1[8 * s2], p1[8 * s2 + 1]); u_.y = cvt_pk_bf16(p1[8 * s2 + 2], p1[8 * s2 + 3]); u_.z = cvt_pk_bf16(p1[8 * s2 + 4], p1[8 * s2 + 5]); u_.w = cvt_pk_bf16(p1[8 * s2 + 6], p1[8 * s2 + 7]); }
                pw[s] = __builtin_bit_cast(bf16x8, u_); }
#pragma unroll
            for (int s = 0; s < 4; ++s)
#pragma unroll
                for (int b = 0; b < 4; ++b) { const s16x4 lo = vtr(vb + s * 16 * VS + b * 64), hh = vtr(vb + s * 16 * VS + 8 * VS + b * 64);
                    const bf16x8 vf = (bf16x8){lo[0], lo[1], lo[2], lo[3], hh[0], hh[1], hh[2], hh[3]};
                    o[b] = __builtin_amdgcn_mfma_f32_32x32x16_bf16(vf, pw[s], o[b], 0, 0, 0); }
        }
        if (t + 1 < NT) ATT_STORE((t + 1) & 1);
    }
#undef ATT_LOAD
#undef ATT_STORE
    __syncthreads();
    l += __shfl_xor(l, 32); const float inv = 1.0f / l;
    LAS float* ex = (LAS float*)lds + wq * 4096;
    if (c == 1) {
#pragma unroll
        for (int b = 0; b < 4; ++b)
#pragma unroll
            for (int r = 0; r < 16; ++r) ex[(32 * b + crow(r, hi)) * 32 + r32] = o[b][r] * inv;
    }
    __syncthreads();
    if (c == 0) {
        float ss = 0.f;
#pragma unroll
        for (int b = 0; b < 4; ++b)
#pragma unroll
            for (int r = 0; r < 16; ++r) { const float v = o[b][r] * inv - lam * ex[(32 * b + crow(r, hi)) * 32 + r32]; o[b][r] = v; ss += v * v; }
        ss += __shfl_xor(ss, 32);
        const float rn = __builtin_amdgcn_rsqf(ss * (1.0f / 128.0f) + 1e-6f) * oscale;
        const int row = q0 + r32;
#pragma unroll
        for (int b = 0; b < 4; ++b)
#pragma unroll
            for (int g = 0; g < 4; ++g) { const int dv = 32 * b + 8 * g + 4 * hi;
                const v2u z = *(const v2u*)(ZB + (size_t)row * 1024 + 128 * h + dv); const f32x4 sg = *(const f32x4*)(subg + dv);
                v2u wv; wv.x = cvt_pk_bf16(o[b][4 * g] * rn * sg.x * bf_lo(z.x), o[b][4 * g + 1] * rn * sg.y * bf_hi(z.x)); wv.y = cvt_pk_bf16(o[b][4 * g + 2] * rn * sg.z * bf_lo(z.y), o[b][4 * g + 3] * rn * sg.w * bf_hi(z.y));
                *(v2u*)(YCAT + (size_t)S_ * 1024 + (size_t)row * 1024 + 128 * h + dv) = wv; }
    }
    __syncthreads();
}
}

__global__ void __launch_bounds__(512, 2) mega_fwd(Args args) {
    extern __shared__ __attribute__((aligned(16))) unsigned char lds_raw[];
    LAS unsigned char* lds = (LAS unsigned char*)lds_raw;
    int tid = threadIdx.x, lane = tid & 63, wave = __builtin_amdgcn_readfirstlane(tid >> 6);
#define RELAUNDER() do { tid = threadIdx.x; asm volatile("" : "+v"(tid)); lane = tid & 63; wave = __builtin_amdgcn_readfirstlane(tid >> 6); } while (0)
    unsigned char* ws = args.ws;
    const int lo = args.ph_lo, hi = args.ph_hi;
#define IN(k) (lo <= (k) && (k) < hi)
#define SEAM(k) do { if (IN(k) && IN((k) + 1)) cg::this_grid().sync(); } while (0)
    if (IN(0)) {
#ifndef NO_PRO
 prologue(args, lds, tid, lane, wave);
#endif
 }
    SEAM(0);
    bf16* Hb = (bf16*)(ws + WS_H); bf16* Qb = (bf16*)(ws + WS_Q); bf16* Kb = (bf16*)(ws + WS_K); bf16* Vb = (bf16*)(ws + WS_V); bf16* VG = (bf16*)(ws + WS_VG); bf16* GG = (bf16*)(ws + WS_GG);
    bf16* ZB = (bf16*)(ws + WS_ZB); bf16* Rb = (bf16*)(ws + WS_R); bf16* SBb = (bf16*)(ws + WS_SB); bf16* YC = (bf16*)(ws + WS_YCAT); bf16* MG = (bf16*)(ws + WS_MG); float* XW = (float*)(ws + WS_X);
    for (int l = 0; l < DEPTH; ++l) {
        const int pb = 1 + 5 * l;
        const float* mod = (const float*)(ws + WS_MOD) + l * 6144;
        const float* xin = (l == 0) ? args.in[0] : XW; float* xout = (l == DEPTH - 1) ? args.out : XW;
#ifndef NO_NORM
        RELAUNDER();
        if (IN(pb)) norm_phase(xin, args.in[4] + l * D_, mod, Hb, lane, wave);
#endif
        SEAM(pb);
        if (IN(pb + 1)) {
            pg8::Gemm g{Hb, (const bf16*)(ws + WS_WIN) + (size_t)l * DIN * D_, S_, DIN, D_}; pg8::StaticOrder S; S.init(S_, DIN, gridDim.x, (int)blockIdx.x);
            pg8::InProjEpi E{Qb, Kb, Vb, VG, GG, ZB, Rb, SBb, args.in[8] + l * 64, args.in[9] + l * 64, (const float*)(ws + WS_ROPE), 0.125f * L2E};
#ifndef NO_INPROJ
            pg8::gemm_phase<pg8::InProjEpi, pg8::StaticOrder, true, true>(lds, g, S, E);
#endif
        }
        SEAM(pb + 1);
        if (IN(pb + 2)) { RELAUNDER();
#ifndef NO_CONV
            conv_phase(VG, GG, args.in[6] + l * 3 * 1024, YC, tid);
#endif
            const float s1 = wave_sum(args.in[10][l * 64 + lane] * args.in[11][l * 64 + lane]), s2 = wave_sum(args.in[12][l * 64 + lane] * args.in[13][l * 64 + lane]);
            const float linit = 0.8f - 0.6f * expf(-0.3f * (float)l); const float lam = expf(s1) - expf(s2) + linit;
#ifndef NO_ATT
            for (int pr = blockIdx.x; pr < 256; pr += gridDim.x) { const int h = pr & 7, pi = pr >> 3;
                att::unit(lds, Qb, Kb, Vb, ZB, YC, args.in[14] + l * 128, lam, 1.0f - linit, h, 63 - pi, tid, lane, wave);
                att::unit(lds, Qb, Kb, Vb, ZB, YC, args.in[14] + l * 128, lam, 1.0f - linit, h, pi, tid, lane, wave); }
#endif
        }
        SEAM(pb + 2);
        if (IN(pb + 3)) {
            pg8::StaticOrder S; S.init(S_, D_, gridDim.x, (int)blockIdx.x); float* Tb = (float*)(ws + WS_T);
#ifndef NO_MERGE
            { pg8::Gemm g{YC, (const bf16*)(ws + WS_WOUT) + (size_t)l * D_ * D_, S_, D_, 1024}; pg8::Merge1Epi E{Rb, Tb};
              pg8::gemm_phase<pg8::Merge1Epi, pg8::StaticOrder, true, true>(lds, g, S, E); }
            { pg8::Gemm g{YC + (size_t)S_ * 1024, (const bf16*)(ws + WS_WOUT) + (size_t)l * D_ * D_ + (size_t)D_ * 1024, S_, D_, 1024}; pg8::Merge2Epi E{SBb, Tb, MG};
              pg8::gemm_phase<pg8::Merge2Epi, pg8::StaticOrder, true, true>(lds, g, S, E); }
#endif
        }
        SEAM(pb + 3);
        if (IN(pb + 4)) {
            pg8::Gemm g{MG, (const bf16*)(ws + WS_WO) + (size_t)l * D_ * D_, S_, D_, D_}; pg8::StaticOrder S; S.init(S_, D_, gridDim.x, (int)blockIdx.x);
            pg8::ResEpi E{xin, xout, mod + 4096};
#ifndef NO_RES
            pg8::gemm_phase<pg8::ResEpi, pg8::StaticOrder, true, true>(lds, g, S, E);
#endif
        }
        SEAM(pb + 4);
    }
#undef IN
#undef SEAM
}
constexpr int N_PHASES = 1 + 5 * DEPTH;

extern "C" void kernel_launch(void* const* d_in, const int* in_sizes, int n_in, void* d_out, int out_size, void* d_ws, size_t ws_size, hipStream_t stream) {
    static int grid = 0;
    if (grid == 0) {
        if (n_in != 17 || out_size != S_ * D_ || ws_size < WS_END) { fprintf(stderr, "kernel_launch: unexpected shapes (n_in %d out %d ws %zu)\n", n_in, out_size, ws_size); grid = -1; return; }
        int dev = 0, cus = 0, per_cu = 0;
        hipGetDevice(&dev); hipDeviceGetAttribute(&cus, hipDeviceAttributeMultiprocessorCount, dev);
        if (hipFuncSetAttribute((const void*)mega_fwd, hipFuncAttributeMaxDynamicSharedMemorySize, LDS_BYTES) != hipSuccess) { fprintf(stderr, "kernel_launch: hipFuncSetAttribute failed\n"); grid = -1; return; }
        if (hipOccupancyMaxActiveBlocksPerMultiprocessor(&per_cu, (const void*)mega_fwd, 512, LDS_BYTES) != hipSuccess || per_cu < 1) { fprintf(stderr, "kernel_launch: occupancy query says %d\n", per_cu); per_cu = 1; }
        (void)hipGetLastError();
        grid = cus * 1;
        if (grid > 256) grid = 256;
    }
    if (grid < 0) return;
    Args a{};
    for (int i = 0; i < 17; ++i) a.in[i] = (const float*)d_in[i];
    a.out = (float*)d_out; a.ws = (unsigned char*)d_ws;
#if MK_MULTI
    for (int p = 0; p < N_PHASES; ++p) { a.ph_lo = p; a.ph_hi = p + 1; hipLaunchKernelGGL(mega_fwd, dim3(grid), dim3(512), LDS_BYTES, stream, a); }
#else
    a.ph_lo = 0; a.ph_hi = N_PHASES;
    void* kargs[] = {&a};
    hipError_t e = hipLaunchCooperativeKernel((const void*)mega_fwd, dim3(grid), dim3(512), kargs, LDS_BYTES, stream);
    if (e != hipSuccess) fprintf(stderr, "cooperative launch failed: %s (grid %d)\n", hipGetErrorString(e), grid);
#endif
}
```

```cpp
#include <hip/hip_runtime.h>
#include <hip/hip_cooperative_groups.h>
#include <cstdio>
#include <cstdint>
namespace cg = cooperative_groups;
#ifndef REP_PRO
#define REP_PRO 1
#endif
#ifndef REP_NORM
#define REP_NORM 1
#endif
#ifndef REP_INPROJ
#define REP_INPROJ 1
#endif
#ifndef REP_ATT
#define REP_ATT 1
#endif
#ifndef REP_MERGE
#define REP_MERGE 1
#endif
#ifndef MK_MULTI
#define MK_MULTI 0
#endif
namespace pg8 {
#define PG8_LAS __attribute__((address_space(3)))
typedef unsigned short bf16_t;
typedef short bf16x8 __attribute__((ext_vector_type(8)));
typedef float f32x4 __attribute__((ext_vector_type(4)));
typedef unsigned u32x4 __attribute__((ext_vector_type(4)));
constexpr int BM = 256, BK = 64, HALF = 128, HTB = HALF * BK * 2  , STAGE_BYTES = 8 * HTB, NXCD = 8, WGM = 8;

__host__ __device__ __forceinline__ int lds_byte(int r, int c) { const int st = (r >> 4) * 2 + (c >> 5), rr = r & 15, cc = c & 31, ob = rr * 64 + cc * 2; return st * 1024 + (ob ^ (((ob >> 9) & 1) << 5)); }
__host__ __device__ __forceinline__ void stage_rc(int b, int& R, int& C) { const int st = b / 1024, sb = b % 1024, swz = sb ^ (((sb >> 9) & 1) << 5); R = (st >> 1) * 16 + swz / 64; C = (st & 1) * 32 + (swz % 64) / 2; }
__host__ __device__ __forceinline__ int perm32(int rho) { const int n = rho >> 4, i = rho & 15; return 8 * (i >> 2) + 4 * n + (i & 3); }

struct Unit { int pm, pn; };
struct Gemm { const bf16_t* A; const bf16_t* Bt; int M, N, K; };

struct StaticOrder {
    int nM, nN, nwg, G, c;
    __host__ __device__ void init(int M, int N, int G_, int c_) { nM = M / BM; nN = N / BM; nwg = nM * nN; G = G_; c = c_; }
    __host__ __device__ bool next(int i, Unit& u) const {
        const long L = (long)i * G + c; if (L >= nwg) return false;
        int wgid = (int)L; { const int q = nwg / NXCD, r = nwg % NXCD, xcd = wgid % NXCD, off = wgid / NXCD; wgid = (xcd < r ? xcd * (q + 1) : r * (q + 1) + (xcd - r) * q) + off; }
        const int nig = WGM * nN, gid = wgid / nig, fm = gid * WGM, gsz = (nM - fm) < WGM ? (nM - fm) : WGM;
        u.pm = fm + ((wgid % nig) % gsz); u.pn = (wgid % nig) / gsz; return true;
    }
    __device__ __forceinline__ void a_ready(const Unit&) const {}
    __device__ __forceinline__ void done(const Unit&) const {}
};

__device__ __forceinline__ unsigned cvt_pk_bf16(float lo, float hi) { unsigned r; asm volatile("v_cvt_pk_bf16_f32 %0, %1, %2" : "=v"(r) : "v"(lo), "v"(hi)); return r; }
__device__ __forceinline__ float bf_lo(unsigned w) { return __uint_as_float(w << 16); }
__device__ __forceinline__ float bf_hi(unsigned w) { return __uint_as_float(w & 0xffff0000u); }
__device__ __forceinline__ float fexp2(float x) { return __builtin_amdgcn_exp2f(x); }
__device__ __forceinline__ float frcp(float x) { return __builtin_amdgcn_rcpf(x); }
constexpr float L2E = 1.4426950408889634f;
__device__ __forceinline__ float silu_f(float x) { return x * frcp(1.0f + fexp2(-x * L2E)); }
__device__ __forceinline__ u32x4 pack8(const f32x4 a, const f32x4 b) { u32x4 w; w.x = cvt_pk_bf16(a[0], a[1]); w.y = cvt_pk_bf16(a[2], a[3]); w.z = cvt_pk_bf16(b[0], b[1]); w.w = cvt_pk_bf16(b[2], b[3]); return w; }

struct InProjEpi {
    static constexpr bool PERM = true, AFTER_DRAIN = false;
    bf16_t *Q, *Kb, *V, *VG, *GG, *ZB, *R, *SB; const float* qg; const float* kg; const float* rope; float qscale;
    __device__ __forceinline__ void operator()(const f32x4 (&acc)[2][2][4][2], const Unit& u, int wr, int wc, int fr, int fq) const {
        const int pn = u.pn; const int row0 = u.pm * BM + wr * 64 + fr;
        if (pn < 16) {
            const bool bz = pn >= 8; const int jt = pn & 7; bf16_t* out = bz ? GG : VG; const int col = jt * 128 + wc * 32 + 8 * fq;
#pragma unroll
            for (int ai = 0; ai < 2; ++ai)
#pragma unroll
                for (int m = 0; m < 4; ++m) { const int row = row0 + ai * HALF + m * 16;
                    f32x4 a0 = acc[ai][0][m][0], a1 = acc[ai][0][m][1], b0 = acc[ai][1][m][0], b1 = acc[ai][1][m][1];
                    if (bz) {
#pragma unroll
                        for (int j = 0; j < 4; ++j) { b0[j] = silu_f(b0[j]); b1[j] = silu_f(b1[j]); } }
                    *(u32x4*)(out + (size_t)row * 1024 + col) = pack8(a0 * b0, a1 * b1); }
        } else if (pn < 24) {
            const bool isk = pn >= 20; const int jt = (pn - 16) & 3; const float* gw = isk ? kg : qg; bf16_t* out = isk ? Kb : Q;
            const int d0 = 8 * fq; const int colbase = 64 * (4 * jt + wc) + d0; const float sc = isk ? 1.0f : qscale;
            const f32x4 gl0 = *(const f32x4*)(gw + d0), gl1 = *(const f32x4*)(gw + d0 + 4), gh0 = *(const f32x4*)(gw + 32 + d0), gh1 = *(const f32x4*)(gw + 32 + d0 + 4);
#pragma unroll
            for (int ai = 0; ai < 2; ++ai)
#pragma unroll
                for (int m = 0; m < 4; ++m) { const int row = row0 + ai * HALF + m * 16;
                    const f32x4 xl0 = acc[ai][0][m][0], xl1 = acc[ai][0][m][1], xh0 = acc[ai][1][m][0], xh1 = acc[ai][1][m][1];
                    float ss = 0.f;
#pragma unroll
                    for (int j = 0; j < 4; ++j) ss += xl0[j] * xl0[j] + xl1[j] * xl1[j] + xh0[j] * xh0[j] + xh1[j] * xh1[j];
                    ss += __shfl_xor(ss, 16); ss += __shfl_xor(ss, 32);
                    const float rn = __builtin_amdgcn_rsqf(ss * (1.0f / 64.0f) + 1e-6f);
                    const f32x4* rp = (const f32x4*)(rope + ((size_t)row * 32 + d0) * 2);
                    const f32x4 c0 = rp[0], c1 = rp[1], c2 = rp[2], c3 = rp[3];
                    const f32x4 al0 = xl0 * rn * gl0, al1 = xl1 * rn * gl1, ah0 = xh0 * rn * gh0, ah1 = xh1 * rn * gh1;
                    f32x4 ol0, ol1, oh0, oh1;
                    ol0[0] = al0[0] * c0[0] - ah0[0] * c0[1]; oh0[0] = ah0[0] * c0[0] + al0[0] * c0[1];
                    ol0[1] = al0[1] * c0[2] - ah0[1] * c0[3]; oh0[1] = ah0[1] * c0[2] + al0[1] * c0[3];
                    ol0[2] = al0[2] * c1[0] - ah0[2] * c1[1]; oh0[2] = ah0[2] * c1[0] + al0[2] * c1[1];
                    ol0[3] = al0[3] * c1[2] - ah0[3] * c1[3]; oh0[3] = ah0[3] * c1[2] + al0[3] * c1[3];
                    ol1[0] = al1[0] * c2[0] - ah1[0] * c2[1]; oh1[0] = ah1[0] * c2[0] + al1[0] * c2[1];
                    ol1[1] = al1[1] * c2[2] - ah1[1] * c2[3]; oh1[1] = ah1[1] * c2[2] + al1[1] * c2[3];
                    ol1[2] = al1[2] * c3[0] - ah1[2] * c3[1]; oh1[2] = ah1[2] * c3[0] + al1[2] * c3[1];
                    ol1[3] = al1[3] * c3[2] - ah1[3] * c3[3]; oh1[3] = ah1[3] * c3[2] + al1[3] * c3[3];
                    *(u32x4*)(out + (size_t)row * 1024 + colbase) = pack8(ol0 * sc, ol1 * sc);
                    *(u32x4*)(out + (size_t)row * 1024 + colbase + 32) = pack8(oh0 * sc, oh1 * sc); }
        } else if (pn < 32) {
            const bool zb = pn >= 28; const int jt = (pn - 24) & 3; bf16_t* out = zb ? ZB : V; const int col = jt * 256 + wc * 32 + 8 * fq;
#pragma unroll
            for (int ai = 0; ai < 2; ++ai)
#pragma unroll
                for (int m = 0; m < 4; ++m) { const int row = row0 + ai * HALF + m * 16;
#pragma unroll
                    for (int bj = 0; bj < 2; ++bj) { f32x4 a0 = acc[ai][bj][m][0], a1 = acc[ai][bj][m][1];
                        if (zb) {
#pragma unroll
                            for (int j = 0; j < 4; ++j) { a0[j] = silu_f(a0[j]); a1[j] = silu_f(a1[j]); } }
                        *(u32x4*)(out + (size_t)row * 1024 + col + bj * HALF) = pack8(a0, a1); } }
        } else {
            const int jt = pn - 32; const int col = jt * 128 + wc * 32 + 8 * fq;
#pragma unroll
            for (int ai = 0; ai < 2; ++ai)
#pragma unroll
                for (int m = 0; m < 4; ++m) { const int row = row0 + ai * HALF + m * 16;
                    f32x4 r0, r1, s0, s1;
#pragma unroll
                    for (int n = 0; n < 2; ++n)
#pragma unroll
                        for (int j = 0; j < 4; ++j) { const float a = acc[ai][0][m][n][j], b = acc[ai][1][m][n][j];
                            const float ea = fexp2(-a * L2E), eb = fexp2(-b * L2E); const float sb = frcp(1.0f + eb), r = frcp(1.0f + ea);
                            if (n == 0) { r0[j] = r; s0[j] = sb; } else { r1[j] = r; s1[j] = sb; } }
                    *(u32x4*)(R + (size_t)row * 2048 + col) = pack8(r0, r1);
                    *(u32x4*)(SB + (size_t)row * 2048 + col) = pack8(s0, s1); }
        }
    }
};
struct Merge1Epi {
    static constexpr bool PERM = true, AFTER_DRAIN = false;
    const bf16_t* SA; float* T;
    __device__ __forceinline__ void operator()(const f32x4 (&acc)[2][2][4][2], const Unit& u, int wr, int wc, int fr, int fq) const {
        const int row0 = u.pm * BM + wr * 64 + fr, col0 = u.pn * BM + wc * 32 + 8 * fq;
#pragma unroll
        for (int ai = 0; ai < 2; ++ai)
#pragma unroll
            for (int m = 0; m < 4; ++m) {
#pragma unroll
                for (int bj = 0; bj < 2; ++bj) { const size_t off = (size_t)(row0 + ai * HALF + m * 16) * 2048 + col0 + bj * HALF; const u32x4 w = *(const u32x4*)(SA + off);
                    *(f32x4*)(T + off) = acc[ai][bj][m][0] * (f32x4){bf_lo(w.x), bf_hi(w.x), bf_lo(w.y), bf_hi(w.y)}; *(f32x4*)(T + off + 4) = acc[ai][bj][m][1] * (f32x4){bf_lo(w.z), bf_hi(w.z), bf_lo(w.w), bf_hi(w.w)}; }
                if (m & 1) asm volatile("" ::: "memory"); }
    }
};
struct Merge2Epi {
    static constexpr bool PERM = true, AFTER_DRAIN = false;
    const bf16_t* SB; const float* T; bf16_t* O;
    __device__ __forceinline__ void operator()(const f32x4 (&acc)[2][2][4][2], const Unit& u, int wr, int wc, int fr, int fq) const {
        const int row0 = u.pm * BM + wr * 64 + fr, col0 = u.pn * BM + wc * 32 + 8 * fq;
#pragma unroll
        for (int ai = 0; ai < 2; ++ai)
#pragma unroll
            for (int m = 0; m < 4; ++m) {
#pragma unroll
                for (int bj = 0; bj < 2; ++bj) { const size_t off = (size_t)(row0 + ai * HALF + m * 16) * 2048 + col0 + bj * HALF; const u32x4 w = *(const u32x4*)(SB + off);
                    const f32x4 t0 = *(const f32x4*)(T + off), t1 = *(const f32x4*)(T + off + 4);
                    const f32x4 a0 = t0 + acc[ai][bj][m][0] * (f32x4){bf_lo(w.x), bf_hi(w.x), bf_lo(w.y), bf_hi(w.y)}, a1 = t1 + acc[ai][bj][m][1] * (f32x4){bf_lo(w.z), bf_hi(w.z), bf_lo(w.w), bf_hi(w.w)};
                    *(u32x4*)(O + off) = pack8(a0, a1); }
                if (m & 1) asm volatile("" ::: "memory"); }
    }
};
struct ResEpi {
    static constexpr bool PERM = false, AFTER_DRAIN = false;
    const float* xin; float* xout; const float* gate;
    __device__ __forceinline__ void operator()(const f32x4 (&acc)[2][2][4][2], const Unit& u, int wr, int wc, int fr, int fq) const {
        const int row0 = u.pm * BM + wr * 64 + fr, col0 = u.pn * BM + wc * 32 + 4 * fq;
        f32x4 gv[2][2];
#pragma unroll
        for (int bj = 0; bj < 2; ++bj)
#pragma unroll
            for (int n = 0; n < 2; ++n) gv[bj][n] = *(const f32x4*)(gate + col0 + bj * HALF + n * 16);
#pragma unroll
        for (int ai = 0; ai < 2; ++ai)
#pragma unroll
            for (int m = 0; m < 4; ++m) { const size_t off = (size_t)(row0 + ai * HALF + m * 16) * 2048 + col0;
#pragma unroll
                for (int bj = 0; bj < 2; ++bj)
#pragma unroll
                    for (int n = 0; n < 2; ++n) { const f32x4 xi = *(const f32x4*)(xin + off + bj * HALF + n * 16);
                        *(f32x4*)(xout + off + bj * HALF + n * 16) = xi + gv[bj][n] * acc[ai][bj][m][n]; } }
    }
};
template <class Epi, class Sched, bool ALIGN_EPI = false, bool SP2 = false>
__device__ __forceinline__ void gemm_phase(PG8_LAS unsigned char* lds, const Gemm g, const Sched& S, const Epi& E) {
    int tid_ = threadIdx.x; asm volatile("" : "+v"(tid_));
    const int tid = tid_, wid = __builtin_amdgcn_readfirstlane(tid >> 6), lane = tid & 63, wr = wid >> 2, wc = wid & 3, fr = lane & 15, fq = lane >> 4;
    const int K = g.K, nt = K / BK;
    unsigned voffA[2], voffB[2];
#pragma unroll
    for (int i = 0; i < 2; ++i) { int R, C; stage_rc(tid * 16 + i * 8192, R, C); const int Rb = Epi::PERM ? ((R & ~31) + perm32(R & 31)) : R;
        voffA[i] = (unsigned)(R * K + C) * 2u; voffB[i] = (unsigned)(Rb * K + C) * 2u; }
    const size_t kstep = (size_t)(BK * 2);
    const size_t hstep = (size_t)HALF * K * 2;
    const size_t tstep = 2 * hstep;
    const unsigned ldsw = (unsigned)wid * 1024u;
    const int aoff = lds_byte(wr * 64 + fr, fq * 8), boff = lds_byte(wc * 32 + fr, fq * 8);
#define PG8_SA(b, h) (((b) * 2 + (h)) * HTB)
#define PG8_SB(b, h) ((4 + (b) * 2 + (h)) * HTB)
#define PG8_STAGE(bufoff, gbase, voff) do { _Pragma("unroll") for (int _i = 0; _i < 2; ++_i) \
        __builtin_amdgcn_global_load_lds((const unsigned*)((const char*)(gbase) + (voff)[_i]), (PG8_LAS unsigned*)(lds + (bufoff) + ldsw + _i * 8192), 16, 0, 0); } while (0)
#define PG8_LDA(dst, b, h) do { _Pragma("unroll") for (int m = 0; m < 4; ++m) _Pragma("unroll") for (int k = 0; k < 2; ++k) dst[m][k] = *(const PG8_LAS bf16x8*)(lds + PG8_SA(b, h) + aoff + m * 2048 + k * 1024); } while (0)
#define PG8_LDB(dst, b, h) do { _Pragma("unroll") for (int n = 0; n < 2; ++n) _Pragma("unroll") for (int k = 0; k < 2; ++k) dst[n][k] = *(const PG8_LAS bf16x8*)(lds + PG8_SB(b, h) + boff + n * 2048 + k * 1024); } while (0)
#define PG8_MMA(ai, bj, At, Bt) do { __builtin_amdgcn_s_setprio(1); _Pragma("unroll") for (int m = 0; m < 4; ++m) _Pragma("unroll") for (int n = 0; n < 2; ++n) _Pragma("unroll") for (int k = 0; k < 2; ++k) \
        acc[ai][bj][m][n] = __builtin_amdgcn_mfma_f32_16x16x32_bf16(Bt[n][k], At[m][k], acc[ai][bj][m][n], 0, 0, 0); __builtin_amdgcn_s_setprio(0); } while (0)
#define PG8_WAIT_V(n) asm volatile("s_waitcnt vmcnt(" #n ")" ::: "memory")
#define PG8_WAIT_L(n) asm volatile("s_waitcnt lgkmcnt(" #n ")" ::: "memory")
#define PG8_BAR __builtin_amdgcn_s_barrier()
#define PG8_SCHED __builtin_amdgcn_sched_barrier(0)
    Unit cur, nxt; int ui = 0;
    if (!S.next(0, cur)) return;
    f32x4 acc[2][2][4][2];
#pragma unroll
    for (int a = 0; a < 2; ++a)
#pragma unroll
        for (int b = 0; b < 2; ++b)
#pragma unroll
            for (int m = 0; m < 4; ++m)
#pragma unroll
                for (int n = 0; n < 2; ++n) acc[a][b][m][n] = (f32x4){0.f, 0.f, 0.f, 0.f};
    bf16x8 At[4][2], B0[2][2], B1[2][2];
    const char* cA = (const char*)g.A + (size_t)cur.pm * tstep; const char* cB = (const char*)g.Bt + (size_t)cur.pn * tstep;
    S.a_ready(cur);
    if constexpr (SP2) {
        PG8_STAGE(PG8_SB(0, 0), cB, voffB); PG8_STAGE(PG8_SB(0, 1), cB + hstep, voffB); PG8_STAGE(PG8_SA(0, 0), cA, voffA); PG8_STAGE(PG8_SA(0, 1), cA + hstep, voffA);
        if (wr == 1) PG8_BAR;
        PG8_WAIT_V(2); PG8_BAR;
        PG8_STAGE(PG8_SB(1, 0), cB + kstep, voffB); PG8_STAGE(PG8_SA(1, 0), cA + kstep, voffA); PG8_STAGE(PG8_SB(1, 1), cB + hstep + kstep, voffB);
        PG8_WAIT_V(6); PG8_BAR;
    } else {
        PG8_STAGE(PG8_SB(0, 0), cB, voffB); PG8_STAGE(PG8_SA(0, 0), cA, voffA); PG8_STAGE(PG8_SB(0, 1), cB + hstep, voffB); PG8_STAGE(PG8_SA(0, 1), cA + hstep, voffA);
        if (wr == 1) PG8_BAR;
        PG8_WAIT_V(4); PG8_BAR;
        PG8_STAGE(PG8_SB(1, 0), cB + kstep, voffB); PG8_STAGE(PG8_SA(1, 0), cA + kstep, voffA); PG8_STAGE(PG8_SB(1, 1), cB + hstep + kstep, voffB);
        PG8_WAIT_V(6); PG8_BAR;
    }
    for (;;) {
        const bool has_next = S.next(ui + 1, nxt);
        const char* nA = has_next ? (const char*)g.A + (size_t)nxt.pm * tstep : cA; const char* nB = has_next ? (const char*)g.Bt + (size_t)nxt.pn * tstep : cB;
        for (int t = 0; t < nt; t += 2) {
            const bool last = (t == nt - 2);
            const char* a1 = cA + (size_t)(t + 1) * kstep;
            const char* a2 = last ? nA : cA + (size_t)(t + 2) * kstep; const char* b2 = last ? nB : cB + (size_t)(t + 2) * kstep;
            const char* a3 = a2 + kstep; const char* b3 = b2 + kstep;
            if (last && has_next) S.a_ready(nxt);
            if constexpr (SP2) {
            PG8_LDB(B0, 0, 0); PG8_LDB(B1, 0, 1); PG8_SCHED; PG8_LDA(At, 0, 0); PG8_STAGE(PG8_SA(1, 1), a1 + hstep, voffA);
            PG8_WAIT_V(8); PG8_WAIT_L(0); PG8_BAR; PG8_MMA(0, 0, At, B0); PG8_MMA(0, 1, At, B1); PG8_BAR; PG8_SCHED;
            PG8_LDA(At, 0, 1); PG8_STAGE(PG8_SB(0, 0), b2, voffB); PG8_STAGE(PG8_SB(0, 1), b2 + hstep, voffB); PG8_STAGE(PG8_SA(0, 0), a2, voffA);
            PG8_WAIT_V(8); PG8_WAIT_L(0); PG8_BAR; PG8_MMA(1, 0, At, B0); PG8_MMA(1, 1, At, B1); PG8_BAR; PG8_SCHED;
            PG8_LDB(B0, 1, 0); PG8_LDB(B1, 1, 1); PG8_SCHED; PG8_LDA(At, 1, 0); PG8_STAGE(PG8_SA(0, 1), a2 + hstep, voffA);
            PG8_WAIT_V(8); PG8_WAIT_L(0); PG8_BAR; PG8_MMA(0, 0, At, B0); PG8_MMA(0, 1, At, B1); PG8_BAR; PG8_SCHED;
            PG8_LDA(At, 1, 1); PG8_STAGE(PG8_SB(1, 0), b3, voffB); PG8_STAGE(PG8_SB(1, 1), b3 + hstep, voffB); PG8_STAGE(PG8_SA(1, 0), a3, voffA);
            PG8_WAIT_V(8); PG8_WAIT_L(0); PG8_BAR; PG8_MMA(1, 0, At, B0); PG8_MMA(1, 1, At, B1); PG8_BAR; PG8_SCHED;
            } else {
            PG8_LDB(B0, 0, 0); PG8_SCHED; PG8_LDA(At, 0, 0); PG8_STAGE(PG8_SA(1, 1), a1 + hstep, voffA);
            PG8_WAIT_L(8); PG8_BAR; PG8_WAIT_L(0); PG8_MMA(0, 0, At, B0); PG8_BAR; PG8_SCHED;
            PG8_LDB(B1, 0, 1); PG8_STAGE(PG8_SB(0, 0), b2, voffB);
            PG8_BAR; PG8_WAIT_L(0); PG8_MMA(0, 1, At, B1); PG8_BAR;
            PG8_LDA(At, 0, 1); PG8_STAGE(PG8_SA(0, 0), a2, voffA);
            PG8_BAR; PG8_WAIT_L(0); PG8_MMA(1, 0, At, B0); PG8_BAR; PG8_SCHED;
            PG8_STAGE(PG8_SB(0, 1), b2 + hstep, voffB);
            PG8_WAIT_V(6); PG8_BAR; PG8_MMA(1, 1, At, B1); PG8_BAR;
            PG8_LDB(B0, 1, 0); PG8_SCHED; PG8_LDA(At, 1, 0); PG8_STAGE(PG8_SA(0, 1), a2 + hstep, voffA);
            PG8_WAIT_L(8); PG8_BAR; PG8_WAIT_L(0); PG8_MMA(0, 0, At, B0); PG8_BAR; PG8_SCHED;
            PG8_LDB(B1, 1, 1); PG8_STAGE(PG8_SB(1, 0), b3, voffB);
            PG8_BAR; PG8_WAIT_L(0); PG8_MMA(0, 1, At, B1); PG8_BAR;
            PG8_LDA(At, 1, 1); PG8_STAGE(PG8_SA(1, 0), a3, voffA);
            PG8_BAR; PG8_WAIT_L(0); PG8_MMA(1, 0, At, B0); PG8_BAR; PG8_SCHED;
            PG8_STAGE(PG8_SB(1, 1), b3 + hstep, voffB);
            PG8_WAIT_V(6); PG8_BAR; PG8_MMA(1, 1, At, B1); PG8_BAR;
            }
        }
        if constexpr (ALIGN_EPI) { if (wr == 0) PG8_BAR; }
        if constexpr (!Epi::AFTER_DRAIN) { E(acc, cur, wr, wc, fr, fq); S.done(cur); }
        if (!has_next) break;
#pragma unroll
        for (int a = 0; a < 2; ++a)
#pragma unroll
            for (int b = 0; b < 2; ++b)
#pragma unroll
                for (int m = 0; m < 4; ++m)
#pragma unroll
                    for (int n = 0; n < 2; ++n) acc[a][b][m][n] = (f32x4){0.f, 0.f, 0.f, 0.f};
        cur = nxt; cA = nA; cB = nB; ++ui;
        if constexpr (ALIGN_EPI) { if (wr == 1) PG8_BAR; }
    }
    PG8_WAIT_V(0);
    if constexpr (!ALIGN_EPI) { if (wr == 0) PG8_BAR; }
    PG8_BAR;
    if constexpr (Epi::AFTER_DRAIN) { E.fused(acc, cur, wr, wc, fr, fq, lds, wid, lane); S.done(cur); }
#undef PG8_SA
#undef PG8_SB
#undef PG8_STAGE
#undef PG8_LDA
#undef PG8_LDB
#undef PG8_MMA
#undef PG8_WAIT_V
#undef PG8_WAIT_L
#undef PG8_BAR
#undef PG8_SCHED
}
}
constexpr int S_ = 8192, D_ = 2048, DIN = 12288, DEPTH = 4;
constexpr size_t MiB = 1u << 20;
constexpr size_t WS_CTL = 3 * MiB, CTL_BYTES = 65536;
constexpr size_t WS_MOD = 0, WS_ROPE = 1 * MiB, WS_WIN = 4 * MiB, WS_WOUT = 196 * MiB, WS_WO = 228 * MiB, WS_H = 260 * MiB, WS_Q = 292 * MiB, WS_K = 308 * MiB, WS_V = 324 * MiB,
                 WS_VG = 340 * MiB, WS_GG = 356 * MiB, WS_ZB = 372 * MiB, WS_R = 388 * MiB, WS_SB = 420 * MiB, WS_YCAT = 452 * MiB, WS_MG = 484 * MiB, WS_X = 516 * MiB, WS_T = 580 * MiB, WS_END = 644 * MiB;
constexpr int LDS_BYTES = 147456;
#define LAS __attribute__((address_space(3)))
typedef unsigned short bf16;
typedef unsigned v4u __attribute__((ext_vector_type(4)));
typedef unsigned v2u __attribute__((ext_vector_type(2)));
typedef float f32x4 __attribute__((ext_vector_type(4)));
typedef float f32x16 __attribute__((ext_vector_type(16)));
typedef short bf16x8 __attribute__((ext_vector_type(8)));
typedef short s16x4 __attribute__((ext_vector_type(4)));
using pg8::cvt_pk_bf16; using pg8::bf_lo; using pg8::bf_hi; using pg8::fexp2; using pg8::frcp; using pg8::L2E;

struct Args { const float* in[17]; float* out; unsigned char* ws; int ph_lo, ph_hi; };

__device__ __forceinline__ float wave_sum(float v) {
#pragma unroll
    for (int o = 1; o < 64; o <<= 1) v += __shfl_xor(v, o);
    return v;
}
__device__ __forceinline__ int map_in(int n0) {
    if (n0 < 4096) { const int seg = n0 >> 10, ch = n0 & 1023; const int tile = ((seg & 1) ? 8 : 0) + (ch >> 7); return tile * 256 + ((seg >> 1) ? 128 : 0) + (ch & 127); }
    if (n0 < 6144) { const int isk = n0 >= 5120, e = n0 - (isk ? 5120 : 4096), g = e >> 6, d = e & 63; return (16 + 4 * isk + (g >> 2)) * 256 + 128 * (d >> 5) + 32 * (g & 3) + (d & 31); }
    if (n0 < 8192) return n0;
    { const int isb = n0 >= 10240, j = n0 - (isb ? 10240 : 8192); return (32 + (j >> 7)) * 256 + 128 * isb + (j & 127); }
}
__device__ __forceinline__ void transpose_item(const float* W, int N, bf16* WT, int ldd, int koff, int k0, int n0, int drow0, LAS float* scr, int lane) {
#pragma unroll 8
    for (int i = 0; i < 32; ++i) { const int kk = 2 * i + (lane >> 5); scr[kk * 33 + (lane & 31)] = W[(size_t)(k0 + kk) * N + n0 + (lane & 31)]; }
    asm volatile("s_waitcnt lgkmcnt(0)" ::: "memory");
    const int c = lane & 7;
#pragma unroll
    for (int j = 0; j < 4; ++j) { const int n = (lane >> 3) + 8 * j; const LAS float* s = scr + (8 * c) * 33 + n;
        v4u o; o.x = cvt_pk_bf16(s[0 * 33], s[1 * 33]); o.y = cvt_pk_bf16(s[2 * 33], s[3 * 33]); o.z = cvt_pk_bf16(s[4 * 33], s[5 * 33]); o.w = cvt_pk_bf16(s[6 * 33], s[7 * 33]);
        *(v4u*)(WT + (size_t)(drow0 + n) * ldd + koff + k0 + 8 * c) = o; }
    asm volatile("s_waitcnt lgkmcnt(0)" ::: "memory");
}
__device__ __forceinline__ void prologue(const Args& a, LAS unsigned char* lds, int tid, int lane, int wave) {
    unsigned char* ws = a.ws;
    if (blockIdx.x < 192 || gridDim.x < 192) {
        LAS float* cact = (LAS float*)lds; LAS float* red = (LAS float*)(lds + 8192);
        for (int i = tid; i < D_; i += 512) { const float v = a.in[1][i]; cact[i] = pg8::silu_f(v); }
        __syncthreads();
        for (int cgi = blockIdx.x; cgi < 192; cgi += gridDim.x) {
            const int l = cgi / 48, col0 = (cgi % 48) * 128 + 2 * lane;
            const float* w = a.in[2] + (size_t)l * D_ * 6144 + col0; float s0 = 0.f, s1 = 0.f;
#pragma unroll 8
            for (int k = wave * 256; k < wave * 256 + 256; ++k) { const float2 v = *(const float2*)(w + (size_t)k * 6144); const float cv = cact[k]; s0 += cv * v.x; s1 += cv * v.y; }
            red[wave * 128 + 2 * lane] = s0; red[wave * 128 + 2 * lane + 1] = s1;
            __syncthreads();
            if (tid < 128) { float s = a.in[3][l * 6144 + (cgi % 48) * 128 + tid];
#pragma unroll
                for (int w8 = 0; w8 < 8; ++w8) s += red[w8 * 128 + tid];
                ((float*)(ws + WS_MOD))[l * 6144 + (cgi % 48) * 128 + tid] = s; }
            __syncthreads();
        }
    }
    for (int e = blockIdx.x * 512 + tid; e < S_ * 32; e += gridDim.x * 512) {
        const int pos = e >> 5, i = e & 31; const float inv = exp2f(-(float)i * (13.287712379549449f / 32.0f)); const float ang = (float)pos * inv;
        const double rev = (double)ang * 0.15915494309189535; const float fr = (float)(rev - floor(rev));
        ((float2*)(ws + WS_ROPE))[e] = make_float2(__builtin_amdgcn_cosf(fr), __builtin_amdgcn_sinf(fr));
    }
    LAS float* scr = (LAS float*)(lds + wave * 16384);
    const int gw = blockIdx.x * 8 + wave, NGW = gridDim.x * 8;
    constexpr int I_IN = 32 * 384, I_C = 16 * 64, I_A = 16 * 64, I_O = 32 * 64, I_L = I_IN + I_C + I_A + I_O;
    for (int it = gw; it < DEPTH * I_L; it += NGW) {
        const int l = it / I_L; int r = it % I_L;
        if (r < I_IN) { const int kb = r / 384, nb = r % 384; transpose_item(a.in[5] + (size_t)l * D_ * DIN, DIN, (bf16*)(ws + WS_WIN) + (size_t)l * DIN * D_, D_, 0, 64 * kb, 32 * nb, map_in(32 * nb), scr, lane); continue; } r -= I_IN;
        if (r < I_C) { const int kb = r / 64, nb = r % 64; transpose_item(a.in[7] + (size_t)l * 1024 * D_, D_, (bf16*)(ws + WS_WOUT) + (size_t)l * D_ * D_, 1024, 0, 64 * kb, 32 * nb, 32 * nb, scr, lane); continue; } r -= I_C;
        if (r < I_A) { const int kb = r / 64, nb = r % 64; transpose_item(a.in[15] + (size_t)l * 1024 * D_, D_, (bf16*)(ws + WS_WOUT) + (size_t)l * D_ * D_ + (size_t)D_ * 1024, 1024, 0, 64 * kb, 32 * nb, 32 * nb, scr, lane); continue; } r -= I_A;
        { const int kb = r / 64, nb = r % 64; transpose_item(a.in[16] + (size_t)l * D_ * D_, D_, (bf16*)(ws + WS_WO) + (size_t)l * D_ * D_, D_, 0, 64 * kb, 32 * nb, 32 * nb, scr, lane); }
    }
}
__device__ __forceinline__ void norm_phase(const float* x, const float* g, const float* mod, bf16* H, int lane, int wave) {
    const int gw = blockIdx.x * 8 + wave, NGW = gridDim.x * 8;
    for (int row = gw; row < S_; row += NGW) {
        const f32x4* xr = (const f32x4*)(x + (size_t)row * D_) + lane; f32x4 v[8]; float s = 0.f;
#pragma unroll
        for (int j = 0; j < 8; ++j) { v[j] = xr[64 * j]; s += (v[j].x * v[j].x + v[j].y * v[j].y) + (v[j].z * v[j].z + v[j].w * v[j].w); }
        const float rinv = __builtin_amdgcn_rsqf(wave_sum(s) * (1.0f / D_) + 1e-6f);
        v2u* o8 = (v2u*)(H + (size_t)row * D_) + lane;
#pragma unroll
        for (int j = 0; j < 8; ++j) { const int col = 4 * lane + 256 * j; const f32x4 gg = *(const f32x4*)(g + col), sh = *(const f32x4*)(mod + col), sc = *(const f32x4*)(mod + 2048 + col);
            const f32x4 y = v[j] * rinv * gg * (sc + 1.0f) + sh; v2u w; w.x = cvt_pk_bf16(y.x, y.y); w.y = cvt_pk_bf16(y.z, y.w); o8[64 * j] = w; }
    }
}
__device__ __forceinline__ void conv_phase(const bf16* VG, const bf16* GG, const float* cw, bf16* YCAT, int tid) {
    for (int item = blockIdx.x * 512 + tid; item < 1024 * 128; item += gridDim.x * 512) {
        const int cgp = item & 127, rg = item >> 7, ch = cgp * 8, t0 = rg * 8;
        float w0[8], w1[8], w2[8], v0[8], v1[8];
#pragma unroll
        for (int j = 0; j < 8; ++j) { w0[j] = cw[ch + j]; w1[j] = cw[1024 + ch + j]; w2[j] = cw[2048 + ch + j]; v0[j] = 0.f; v1[j] = 0.f; }
        if (t0 > 0) { const v4u a = *(const v4u*)(VG + (size_t)(t0 - 2) * 1024 + ch), b = *(const v4u*)(VG + (size_t)(t0 - 1) * 1024 + ch);
            v0[0] = bf_lo(a.x); v0[1] = bf_hi(a.x); v0[2] = bf_lo(a.y); v0[3] = bf_hi(a.y); v0[4] = bf_lo(a.z); v0[5] = bf_hi(a.z); v0[6] = bf_lo(a.w); v0[7] = bf_hi(a.w);
            v1[0] = bf_lo(b.x); v1[1] = bf_hi(b.x); v1[2] = bf_lo(b.y); v1[3] = bf_hi(b.y); v1[4] = bf_lo(b.z); v1[5] = bf_hi(b.z); v1[6] = bf_lo(b.w); v1[7] = bf_hi(b.w); }
#pragma unroll
        for (int i = 0; i < 8; ++i) { const v4u a = *(const v4u*)(VG + (size_t)(t0 + i) * 1024 + ch), gq = *(const v4u*)(GG + (size_t)(t0 + i) * 1024 + ch);
            float v2[8], gv[8], y[8];
            v2[0] = bf_lo(a.x); v2[1] = bf_hi(a.x); v2[2] = bf_lo(a.y); v2[3] = bf_hi(a.y); v2[4] = bf_lo(a.z); v2[5] = bf_hi(a.z); v2[6] = bf_lo(a.w); v2[7] = bf_hi(a.w);
            gv[0] = bf_lo(gq.x); gv[1] = bf_hi(gq.x); gv[2] = bf_lo(gq.y); gv[3] = bf_hi(gq.y); gv[4] = bf_lo(gq.z); gv[5] = bf_hi(gq.z); gv[6] = bf_lo(gq.w); gv[7] = bf_hi(gq.w);
#pragma unroll
            for (int j = 0; j < 8; ++j) { y[j] = gv[j] * (w0[j] * v0[j] + w1[j] * v1[j] + w2[j] * v2[j]); v0[j] = v1[j]; v1[j] = v2[j]; }
            v4u o; o.x = cvt_pk_bf16(y[0], y[1]); o.y = cvt_pk_bf16(y[2], y[3]); o.z = cvt_pk_bf16(y[4], y[5]); o.w = cvt_pk_bf16(y[6], y[7]);
            *(v4u*)(YCAT + (size_t)(t0 + i) * 1024 + ch) = o; }
    }
}
namespace att {
constexpr int KS = 144, VS = 320, KT_BYTES = 2 * 64 * KS, VT_BYTES = 64 * VS, BUF = KT_BYTES + VT_BYTES;
constexpr float THR = 8.0f;
__device__ __forceinline__ int crow(int r, int hi) { return (r & 3) + 8 * (r >> 2) + 4 * hi; }
__device__ __forceinline__ s16x4 vtr(const LAS unsigned char* p) { return __builtin_bit_cast(s16x4, __builtin_amdgcn_ds_read_tr16_b64_v4i16((LAS s16x4*)p)); }
__device__ __forceinline__ void unit(LAS unsigned char* lds, const bf16* Q, const bf16* K, const bf16* V, const bf16* ZB, bf16* YCAT, const float* subg, float lam, float oscale, int h, int qb, int tid, int lane, int w) {
    const int c = w >> 2, wq = w & 3, r32 = lane & 31, hi = lane >> 5;
    const int q0 = 128 * qb + 32 * wq, NT = 2 * qb + 2, ntw = (q0 >> 6) + 1;
    bf16x8 qf[4];
    { const bf16* qp = Q + (size_t)(q0 + r32) * 1024 + 128 * h + 64 * c + 8 * hi;
#pragma unroll
      for (int ks = 0; ks < 4; ++ks) qf[ks] = *(const bf16x8*)(qp + 16 * ks); }
    const int key_s = tid >> 4, ch_s = tid & 15;
    const bf16* kg = K + (size_t)key_s * 1024 + 128 * h + ch_s * 8; const bf16* vg = V + (size_t)key_s * 1024 + 128 * h + ch_s * 8;
    const int kdst = (ch_s >> 3) * 64 * KS + key_s * KS + (ch_s & 7) * 16, vdst = KT_BYTES + key_s * VS + ch_s * 16;
    v4u kr[2], vr[2];
#define ATT_LOAD(t) do { _Pragma("unroll") for (int i_ = 0; i_ < 2; ++i_) { kr[i_] = *(const v4u*)(kg + (size_t)(64 * (t) + 32 * i_) * 1024); vr[i_] = *(const v4u*)(vg + (size_t)(64 * (t) + 32 * i_) * 1024); } } while (0)
#define ATT_STORE(b) do { _Pragma("unroll") for (int i_ = 0; i_ < 2; ++i_) { *(LAS v4u*)(lds + (b) * BUF + kdst + 32 * i_ * KS) = kr[i_]; *(LAS v4u*)(lds + (b) * BUF + vdst + 32 * i_ * VS) = vr[i_]; } } while (0)
    ATT_LOAD(0); ATT_STORE(0);
    f32x16 o[4];
#pragma unroll
    for (int b = 0; b < 4; ++b) o[b] = f32x16{};
    float mref = -1e30f, l = 0.f;
    const int kfo = c * 64 * KS + r32 * KS + hi * 16;
    const int vfo = KT_BYTES + (4 * hi + ((lane & 15) >> 2)) * VS + (16 * ((lane >> 4) & 1) + 4 * (lane & 3)) * 2;
    for (int t = 0; t < NT; ++t) {
        __syncthreads();
        if (t + 1 < NT) ATT_LOAD(t + 1);
        if (t < ntw) {
            const LAS unsigned char* kb = lds + (t & 1) * BUF + kfo; const LAS unsigned char* vb = lds + (t & 1) * BUF + vfo;
            f32x16 p0 = f32x16{}, p1 = f32x16{};
#pragma unroll
            for (int ks = 0; ks < 4; ++ks) { const bf16x8 a0 = *(const LAS bf16x8*)(kb + ks * 32), a1 = *(const LAS bf16x8*)(kb + 32 * KS + ks * 32);
                p0 = __builtin_amdgcn_mfma_f32_32x32x16_bf16(a0, qf[ks], p0, 0, 0, 0); p1 = __builtin_amdgcn_mfma_f32_32x32x16_bf16(a1, qf[ks], p1, 0, 0, 0); }
            float rm = fmaxf(p0[0], p1[0]);
#pragma unroll
            for (int r = 1; r < 16; ++r) rm = fmaxf(rm, fmaxf(p0[r], p1[r]));
            rm = fmaxf(rm, __shfl_xor(rm, 32));
            if (__any(rm > mref + THR)) { const float mn = fmaxf(mref, rm); const float al = fexp2(mref - mn); mref = mn; l *= al;
#pragma unroll
                for (int b = 0; b < 4; ++b) o[b] *= al; }
            float ls = 0.f;
#pragma unroll
            for (int r = 0; r < 16; ++r) { p0[r] = fexp2(p0[r] - mref); p1[r] = fexp2(p1[r] - mref); ls += p0[r] + p1[r]; }
            l += ls;
            bf16x8 pw[4];
#pragma unroll
            for (int s = 0; s < 4; ++s) { v4u u_;
                if (s < 2) { u_.x = cvt_pk_bf16(p0[8 * s], p0[8 * s + 1]); u_.y = cvt_pk_bf16(p0[8 * s + 2], p0[8 * s + 3]); u_.z = cvt_pk_bf16(p0[8 * s + 4], p0[8 * s + 5]); u_.w = cvt_pk_bf16(p0[8 * s + 6], p0[8 * s + 7]); }
                else { const int s2 = s - 2; u_.x = cvt_pk_bf16(p1[8 * s2], p1[8 * s2 + 1]); u_.y = cvt_pk_bf16(p1[8 * s2 + 2], p1[8 * s2 + 3]); u_.z = cvt_pk_bf16(p1[8 * s2 + 4], p1[8 * s2 + 5]); u_.w = cvt_pk_bf16(p1[8 * s2 + 6], p1[8 * s2 + 7]); }
                pw[s] = __builtin_bit_cast(bf16x8, u_); }
#pragma unroll
            for (int s = 0; s < 4; ++s)
#pragma unroll
                for (int b = 0; b < 4; ++b) { const s16x4 lo = vtr(vb + s * 16 * VS + b * 64), hh = vtr(vb + s * 16 * VS + 8 * VS + b * 64);
                    const bf16x8 vf = (bf16x8){lo[0], lo[1], lo[2], lo[3], hh[0], hh[1], hh[2], hh[3]};
                    o[b] = __builtin_amdgcn_mfma_f32_32x32x16_bf16(vf, pw[s], o[b], 0, 0, 0); }
        }
        if (t + 1 < NT) ATT_STORE((t + 1) & 1);
    }
#undef ATT_LOAD
#undef ATT_STORE
    __syncthreads();
    l += __shfl_xor(l, 32); const float inv = 1.0f / l;
    LAS float* ex = (LAS float*)lds + wq * 4096;
    if (c == 1) {
#pragma unroll
        for (int b = 0; b < 4; ++b)
#pragma unroll
            for (int r = 0; r < 16; ++r) ex[(32 * b + crow(r, hi)) * 32 + r32] = o[b][r] * inv;
    }
    __syncthreads();
    if (c == 0) {
        float ss = 0.f;
#pragma unroll
        for (int b = 0; b < 4; ++b)
#pragma unroll
            for (int r = 0; r < 16; ++r) { const float v = o[b][r] * inv - lam * ex[(32 * b + crow(r, hi)) * 32 + r32]; o[b][r] = v; ss += v * v; }
        ss += __shfl_xor(ss, 32);
        const float rn = __builtin_amdgcn_rsqf(ss * (1.0f / 128.0f) + 1e-6f) * oscale;
        const int row = q0 + r32;
#pragma unroll
        for (int b = 0; b < 4; ++b)
#pragma unroll
            for (int g = 0; g < 4; ++g) { const int dv = 32 * b + 8 * g + 4 * hi;
                const v2u z = *(const v2u*)(ZB + (size_t)row * 1024 + 128 * h + dv); const f32x4 sg = *(const f32x4*)(subg + dv);
                v2u wv; wv.x = cvt_pk_bf16(o[b][4 * g] * rn * sg.x * bf_lo(z.x), o[b][4 * g + 1] * rn * sg.y * bf_hi(z.x)); wv.y = cvt_pk_bf16(o[b][4 * g + 2] * rn * sg.z * bf_lo(z.y), o[b][4 * g + 3] * rn * sg.w * bf_hi(z.y));
                *(v2u*)(YCAT + (size_t)S_ * 1024 + (size_t)row * 1024 + 128 * h + dv) = wv; }
    }
    __syncthreads();
}
}

#define XB_TMO      128
#define XB_XCNT(j)  (256  + 64 * (j))
#define XB_XSUB(j)  (1280 + 64 * (j))
#define XB_XGEN(j)  (2304 + 64 * (j))
#define XB_TOP      3328
#define XB_TOPGEN   3392
#define XCD_BAR_WORDS 3456
#define XB_SPIN_CAP (1u << 18)

__device__ __forceinline__ unsigned xb_ld(unsigned* p)              { return __hip_atomic_load(p, __ATOMIC_RELAXED, __HIP_MEMORY_SCOPE_AGENT); }
__device__ __forceinline__ unsigned xb_add(unsigned* p, unsigned v) { return __hip_atomic_fetch_add(p, v, __ATOMIC_RELAXED, __HIP_MEMORY_SCOPE_AGENT); }
__device__ __forceinline__ unsigned xb_xcc_id() { return (unsigned)__builtin_amdgcn_s_getreg((3 << 11) | 20) & 0xFu; }
#define XB_SPIN(cond, bar) do { unsigned _sp = 0; while (cond) { __builtin_amdgcn_s_sleep(1); \
    if ((++_sp & 255u) == 0u) { if (xb_ld(&(bar)[XB_TMO])) break; if (_sp > XB_SPIN_CAP) { atomicAdd(&(bar)[XB_TMO], 1u); break; } } } } while (0)

struct XcdBarrier {
    unsigned* bar; unsigned x;
    volatile LAS unsigned* st;
};

__device__ __forceinline__ XcdBarrier xcd_barrier_post(unsigned* bar, volatile LAS unsigned* st) {
    XcdBarrier b; b.bar = bar; b.x = xb_xcc_id(); b.st = st;
    if (threadIdx.x == 0) (void)xb_add(&bar[XB_XCNT(b.x)], 1u);
    return b;
}
__device__ __forceinline__ void xcd_barrier_complete(unsigned* bar, unsigned x, unsigned& nloc, unsigned& nx) {
    const unsigned G = gridDim.x * gridDim.y * gridDim.z;
    unsigned sum, cnt, mine, sp = 0u;
    for (;;) {
        sum = 0u; cnt = 0u; mine = 0u;
#pragma unroll
        for (unsigned j = 0; j < 16; ++j) { const unsigned c = xb_ld(&bar[XB_XCNT(j)]); sum += c; cnt += (c > 0u) ? 1u : 0u; mine = (j == x) ? c : mine; }
        if (sum == G) break;
        __builtin_amdgcn_s_sleep(1);
        if ((++sp & 255u) == 0u) { if (xb_ld(&bar[XB_TMO])) break; if (sp > XB_SPIN_CAP) { atomicAdd(&bar[XB_TMO], 1u); break; } }
    }
    nloc = mine > 0u ? mine : 1u; nx = cnt > 0u ? cnt : 1u;
}

__device__ __forceinline__ void xcd_barrier(const XcdBarrier& b) {
    asm volatile("s_waitcnt vmcnt(0)" ::: "memory");
    __syncthreads();
    if (threadIdx.x == 0) {
        unsigned* bar = b.bar;
        __builtin_amdgcn_s_waitcnt(0);
        unsigned nloc = b.st[0], nx = b.st[1];
        if (nloc == 0u) { xcd_barrier_complete(bar, b.x, nloc, nx); b.st[0] = nloc; b.st[1] = nx; }
        const unsigned old = xb_add(&bar[XB_XSUB(b.x)], 1u);
        const unsigned gen = old / nloc;
        if (old + 1u == (gen + 1u) * nloc) {
            __builtin_amdgcn_fence(__ATOMIC_RELEASE, "agent");
            asm volatile("s_waitcnt vmcnt(0)" ::: "memory");
            const unsigned og = xb_add(&bar[XB_TOP], 1u);
            const unsigned tg = og / nx;
            if (og + 1u == (tg + 1u) * nx) xb_add(&bar[XB_TOPGEN], 1u);
            else XB_SPIN(xb_ld(&bar[XB_TOPGEN]) == tg, bar);
            __builtin_amdgcn_fence(__ATOMIC_ACQUIRE, "agent");
            xb_add(&bar[XB_XGEN(b.x)], 1u);
            asm volatile("s_waitcnt vmcnt(0)" ::: "memory");
        } else {
            XB_SPIN(xb_ld(&bar[XB_XGEN(b.x)]) == gen, bar);
            __builtin_amdgcn_fence(__ATOMIC_ACQUIRE, "agent");
            asm volatile("s_waitcnt vmcnt(0)" ::: "memory");
        }
    }
    __syncthreads();
}

__global__ void __launch_bounds__(512, 2) mega_fwd(Args args) {
    extern __shared__ __attribute__((aligned(16))) unsigned char lds_raw[];
    LAS unsigned char* lds = (LAS unsigned char*)lds_raw;
    int tid = threadIdx.x, lane = tid & 63, wave = __builtin_amdgcn_readfirstlane(tid >> 6);
#define RELAUNDER() do { tid = threadIdx.x; asm volatile("" : "+v"(tid)); lane = tid & 63; wave = __builtin_amdgcn_readfirstlane(tid >> 6); } while (0)
    unsigned char* ws = args.ws;
    const int lo = args.ph_lo, hi = args.ph_hi;
    volatile LAS unsigned* bst = (volatile LAS unsigned*)(lds + 131072 + 32);
    if (tid < 2) bst[tid] = 0u;
    __syncthreads();
    XcdBarrier bar = xcd_barrier_post((unsigned*)(ws + WS_CTL), bst);
#define IN(k) (lo <= (k) && (k) < hi)
#define SEAM(k) do { if (IN(k) && IN((k) + 1)) { if ((k) == 0) cg::this_grid().sync(); else xcd_barrier(bar); } } while (0)
    if (IN(0)) {
#ifndef NO_PRO
 for (int rep_ = 0; rep_ < REP_PRO; ++rep_) { prologue(args, lds, tid, lane, wave); __syncthreads(); }
#endif
 }
    SEAM(0);
    bf16* Hb = (bf16*)(ws + WS_H); bf16* Qb = (bf16*)(ws + WS_Q); bf16* Kb = (bf16*)(ws + WS_K); bf16* Vb = (bf16*)(ws + WS_V); bf16* VG = (bf16*)(ws + WS_VG); bf16* GG = (bf16*)(ws + WS_GG);
    bf16* ZB = (bf16*)(ws + WS_ZB); bf16* Rb = (bf16*)(ws + WS_R); bf16* SBb = (bf16*)(ws + WS_SB); bf16* YC = (bf16*)(ws + WS_YCAT); bf16* MG = (bf16*)(ws + WS_MG); float* XW = (float*)(ws + WS_X);
    for (int l = 0; l < DEPTH; ++l) {
        const int pb = 1 + 5 * l;
        const float* mod = (const float*)(ws + WS_MOD) + l * 6144;
        const float* xin = (l == 0) ? args.in[0] : XW; float* xout = (l == DEPTH - 1) ? args.out : XW;
#ifndef NO_NORM
        RELAUNDER();
        if (IN(pb)) for (int rep_ = 0; rep_ < REP_NORM; ++rep_) norm_phase(xin, args.in[4] + l * D_, mod, Hb, lane, wave);
#endif
        SEAM(pb);
        if (IN(pb + 1)) {
            pg8::Gemm g{Hb, (const bf16*)(ws + WS_WIN) + (size_t)l * DIN * D_, S_, DIN, D_}; pg8::StaticOrder S; S.init(S_, DIN, gridDim.x, (int)blockIdx.x);
            pg8::InProjEpi E{Qb, Kb, Vb, VG, GG, ZB, Rb, SBb, args.in[8] + l * 64, args.in[9] + l * 64, (const float*)(ws + WS_ROPE), 0.125f * L2E};
#ifndef NO_INPROJ
            for (int rep_ = 0; rep_ < REP_INPROJ; ++rep_) pg8::gemm_phase<pg8::InProjEpi, pg8::StaticOrder, true, true>(lds, g, S, E);
#endif
        }
        SEAM(pb + 1);
        if (IN(pb + 2)) { RELAUNDER();
#ifndef NO_CONV
            conv_phase(VG, GG, args.in[6] + l * 3 * 1024, YC, tid);
#endif
            const float s1 = wave_sum(args.in[10][l * 64 + lane] * args.in[11][l * 64 + lane]), s2 = wave_sum(args.in[12][l * 64 + lane] * args.in[13][l * 64 + lane]);
            const float linit = 0.8f - 0.6f * expf(-0.3f * (float)l); const float lam = expf(s1) - expf(s2) + linit;
#ifndef NO_ATT
            for (int rep_ = 0; rep_ < REP_ATT; ++rep_)
            for (int pr = blockIdx.x; pr < 256; pr += gridDim.x) { const int h = pr & 7, pi = pr >> 3;
                att::unit(lds, Qb, Kb, Vb, ZB, YC, args.in[14] + l * 128, lam, 1.0f - linit, h, 63 - pi, tid, lane, wave);
                att::unit(lds, Qb, Kb, Vb, ZB, YC, args.in[14] + l * 128, lam, 1.0f - linit, h, pi, tid, lane, wave); }
#endif
        }
        SEAM(pb + 2);
        if (IN(pb + 3)) {
            pg8::StaticOrder S; S.init(S_, D_, gridDim.x, (int)blockIdx.x); float* Tb = (float*)(ws + WS_T);
#ifndef NO_MERGE
            for (int rep_ = 0; rep_ < REP_MERGE; ++rep_) {
            { pg8::Gemm g{YC, (const bf16*)(ws + WS_WOUT) + (size_t)l * D_ * D_, S_, D_, 1024}; pg8::Merge1Epi E{Rb, Tb};
              pg8::gemm_phase<pg8::Merge1Epi, pg8::StaticOrder, true, true>(lds, g, S, E); }
            { pg8::Gemm g{YC + (size_t)S_ * 1024, (const bf16*)(ws + WS_WOUT) + (size_t)l * D_ * D_ + (size_t)D_ * 1024, S_, D_, 1024}; pg8::Merge2Epi E{SBb, Tb, MG};
              pg8::gemm_phase<pg8::Merge2Epi, pg8::StaticOrder, true, true>(lds, g, S, E); }
            }
#endif
        }
        SEAM(pb + 3);
        if (IN(pb + 4)) {
            pg8::Gemm g{MG, (const bf16*)(ws + WS_WO) + (size_t)l * D_ * D_, S_, D_, D_}; pg8::StaticOrder S; S.init(S_, D_, gridDim.x, (int)blockIdx.x);
            pg8::ResEpi E{xin, xout, mod + 4096};
#ifndef NO_RES
            pg8::gemm_phase<pg8::ResEpi, pg8::StaticOrder, true, true>(lds, g, S, E);
#endif
        }
        SEAM(pb + 4);
    }
#undef IN
#undef SEAM
}
constexpr int N_PHASES = 1 + 5 * DEPTH;

extern "C" void kernel_launch(void* const* d_in, const int* in_sizes, int n_in, void* d_out, int out_size, void* d_ws, size_t ws_size, hipStream_t stream) {
    static int grid = 0;
    if (grid == 0) {
        if (n_in != 17 || out_size != S_ * D_ || ws_size < WS_END) { fprintf(stderr, "kernel_launch: unexpected shapes (n_in %d out %d ws %zu)\n", n_in, out_size, ws_size); grid = -1; return; }
        int dev = 0, cus = 0, per_cu = 0;
        hipGetDevice(&dev); hipDeviceGetAttribute(&cus, hipDeviceAttributeMultiprocessorCount, dev);
        if (hipFuncSetAttribute((const void*)mega_fwd, hipFuncAttributeMaxDynamicSharedMemorySize, LDS_BYTES) != hipSuccess) { fprintf(stderr, "kernel_launch: hipFuncSetAttribute failed\n"); grid = -1; return; }
        if (hipOccupancyMaxActiveBlocksPerMultiprocessor(&per_cu, (const void*)mega_fwd, 512, LDS_BYTES) != hipSuccess || per_cu < 1) { fprintf(stderr, "kernel_launch: occupancy query says %d\n", per_cu); per_cu = 1; }
        (void)hipGetLastError();
        grid = cus * 1;
        if (grid > 256) grid = 256;
    }
    if (grid < 0) return;
    if (hipMemsetAsync((char*)d_ws + WS_CTL, 0, CTL_BYTES, stream) != hipSuccess) { fprintf(stderr, "kernel_launch: memset failed\n"); return; }
    Args a{};
    for (int i = 0; i < 17; ++i) a.in[i] = (const float*)d_in[i];
    a.out = (float*)d_out; a.ws = (unsigned char*)d_ws;
#if MK_MULTI
    for (int p = 0; p < N_PHASES; ++p) { a.ph_lo = p; a.ph_hi = p + 1; hipLaunchKernelGGL(mega_fwd, dim3(grid), dim3(512), LDS_BYTES, stream, a); }
#else
    a.ph_lo = 0; a.ph_hi = N_PHASES;
    void* kargs[] = {&a};
    hipError_t e = hipLaunchCooperativeKernel((const void*)mega_fwd, dim3(grid), dim3(512), kargs, LDS_BYTES, stream);
    if (e != hipSuccess) fprintf(stderr, "cooperative launch failed: %s (grid %d)\n", hipGetErrorString(e), grid);
#endif
}
```

```cpp
#include <hip/hip_runtime.h>
#include <hip/hip_cooperative_groups.h>
#include <cstdio>
#include <cstdint>
namespace cg = cooperative_groups;
#ifndef REP_PRO
#define REP_PRO 1
#endif
#ifndef REP_NORM
#define REP_NORM 1
#endif
#ifndef REP_INPROJ
#define REP_INPROJ 1
#endif
#ifndef REP_ATT
#define REP_ATT 1
#endif
#ifndef REP_MERGE
#define REP_MERGE 1
#endif
#ifndef MK_MULTI
#define MK_MULTI 0
#endif
namespace pg8 {
#define PG8_LAS __attribute__((address_space(3)))
typedef unsigned short bf16_t;
typedef short bf16x8 __attribute__((ext_vector_type(8)));
typedef float f32x4 __attribute__((ext_vector_type(4)));
typedef unsigned u32x4 __attribute__((ext_vector_type(4)));
constexpr int BM = 256, BK = 64, HALF = 128, HTB = HALF * BK * 2  , STAGE_BYTES = 8 * HTB, NXCD = 8, WGM = 8;

__host__ __device__ __forceinline__ int lds_byte(int r, int c) { const int st = (r >> 4) * 2 + (c >> 5), rr = r & 15, cc = c & 31, ob = rr * 64 + cc * 2; return st * 1024 + (ob ^ (((ob >> 9) & 1) << 5)); }
__host__ __device__ __forceinline__ void stage_rc(int b, int& R, int& C) { const int st = b / 1024, sb = b % 1024, swz = sb ^ (((sb >> 9) & 1) << 5); R = (st >> 1) * 16 + swz / 64; C = (st & 1) * 32 + (swz % 64) / 2; }
__host__ __device__ __forceinline__ int perm32(int rho) { const int n = rho >> 4, i = rho & 15; return 8 * (i >> 2) + 4 * n + (i & 3); }

struct Unit { int pm, pn; };
struct Gemm { const bf16_t* A; const bf16_t* Bt; int M, N, K; };

struct StaticOrder {
    int nM, nN, nwg, G, c;
    __host__ __device__ void init(int M, int N, int G_, int c_) { nM = M / BM; nN = N / BM; nwg = nM * nN; G = G_; c = c_; }
    __host__ __device__ bool next(int i, Unit& u) const {
        const long L = (long)i * G + c; if (L >= nwg) return false;
        int wgid = (int)L; { const int q = nwg / NXCD, r = nwg % NXCD, xcd = wgid % NXCD, off = wgid / NXCD; wgid = (xcd < r ? xcd * (q + 1) : r * (q + 1) + (xcd - r) * q) + off; }
        const int nig = WGM * nN, gid = wgid / nig, fm = gid * WGM, gsz = (nM - fm) < WGM ? (nM - fm) : WGM;
        u.pm = fm + ((wgid % nig) % gsz); u.pn = (wgid % nig) / gsz; return true;
    }
    __device__ __forceinline__ void a_ready(const Unit&) const {}
    __device__ __forceinline__ void done(const Unit&) const {}
};

__device__ __forceinline__ unsigned cvt_pk_bf16(float lo, float hi) { unsigned r; asm volatile("v_cvt_pk_bf16_f32 %0, %1, %2" : "=v"(r) : "v"(lo), "v"(hi)); return r; }
__device__ __forceinline__ float bf_lo(unsigned w) { return __uint_as_float(w << 16); }
__device__ __forceinline__ float bf_hi(unsigned w) { return __uint_as_float(w & 0xffff0000u); }
__device__ __forceinline__ float fexp2(float x) { return __builtin_amdgcn_exp2f(x); }
__device__ __forceinline__ float frcp(float x) { return __builtin_amdgcn_rcpf(x); }
constexpr float L2E = 1.4426950408889634f;
__device__ __forceinline__ float silu_f(float x) { return x * frcp(1.0f + fexp2(-x * L2E)); }
__device__ __forceinline__ u32x4 pack8(const f32x4 a, const f32x4 b) { u32x4 w; w.x = cvt_pk_bf16(a[0], a[1]); w.y = cvt_pk_bf16(a[2], a[3]); w.z = cvt_pk_bf16(b[0], b[1]); w.w = cvt_pk_bf16(b[2], b[3]); return w; }

struct InProjEpi {
    static constexpr bool PERM = true, AFTER_DRAIN = false;
    bf16_t *Q, *Kb, *V, *VG, *GG, *ZB, *R, *SB; const float* qg; const float* kg; const float* rope; float qscale;
    __device__ __forceinline__ void operator()(const f32x4 (&acc)[2][2][4][2], const Unit& u, int wr, int wc, int fr, int fq) const {
        const int pn = u.pn; const int row0 = u.pm * BM + wr * 64 + fr;
        if (pn < 16) {
            const bool bz = pn >= 8; const int jt = pn & 7; bf16_t* out = bz ? GG : VG; const int col = jt * 128 + wc * 32 + 8 * fq;
#pragma unroll
            for (int ai = 0; ai < 2; ++ai)
#pragma unroll
                for (int m = 0; m < 4; ++m) { const int row = row0 + ai * HALF + m * 16;
                    f32x4 a0 = acc[ai][0][m][0], a1 = acc[ai][0][m][1], b0 = acc[ai][1][m][0], b1 = acc[ai][1][m][1];
                    if (bz) {
#pragma unroll
                        for (int j = 0; j < 4; ++j) { b0[j] = silu_f(b0[j]); b1[j] = silu_f(b1[j]); } }
                    *(u32x4*)(out + (size_t)row * 1024 + col) = pack8(a0 * b0, a1 * b1); }
        } else if (pn < 24) {
            const bool isk = pn >= 20; const int jt = (pn - 16) & 3; const float* gw = isk ? kg : qg; bf16_t* out = isk ? Kb : Q;
            const int d0 = 8 * fq; const int colbase = 64 * (4 * jt + wc) + d0; const float sc = isk ? 1.0f : qscale;
            const f32x4 gl0 = *(const f32x4*)(gw + d0), gl1 = *(const f32x4*)(gw + d0 + 4), gh0 = *(const f32x4*)(gw + 32 + d0), gh1 = *(const f32x4*)(gw + 32 + d0 + 4);
#pragma unroll
            for (int ai = 0; ai < 2; ++ai)
#pragma unroll
                for (int m = 0; m < 4; ++m) { const int row = row0 + ai * HALF + m * 16;
                    const f32x4 xl0 = acc[ai][0][m][0], xl1 = acc[ai][0][m][1], xh0 = acc[ai][1][m][0], xh1 = acc[ai][1][m][1];
                    float ss = 0.f;
#pragma unroll
                    for (int j = 0; j < 4; ++j) ss += xl0[j] * xl0[j] + xl1[j] * xl1[j] + xh0[j] * xh0[j] + xh1[j] * xh1[j];
                    ss += __shfl_xor(ss, 16); ss += __shfl_xor(ss, 32);
                    const float rn = __builtin_amdgcn_rsqf(ss * (1.0f / 64.0f) + 1e-6f);
                    const f32x4* rp = (const f32x4*)(rope + ((size_t)row * 32 + d0) * 2);
                    const f32x4 c0 = rp[0], c1 = rp[1], c2 = rp[2], c3 = rp[3];
                    const f32x4 al0 = xl0 * rn * gl0, al1 = xl1 * rn * gl1, ah0 = xh0 * rn * gh0, ah1 = xh1 * rn * gh1;
                    f32x4 ol0, ol1, oh0, oh1;
                    ol0[0] = al0[0] * c0[0] - ah0[0] * c0[1]; oh0[0] = ah0[0] * c0[0] + al0[0] * c0[1];
                    ol0[1] = al0[1] * c0[2] - ah0[1] * c0[3]; oh0[1] = ah0[1] * c0[2] + al0[1] * c0[3];
                    ol0[2] = al0[2] * c1[0] - ah0[2] * c1[1]; oh0[2] = ah0[2] * c1[0] + al0[2] * c1[1];
                    ol0[3] = al0[3] * c1[2] - ah0[3] * c1[3]; oh0[3] = ah0[3] * c1[2] + al0[3] * c1[3];
                    ol1[0] = al1[0] * c2[0] - ah1[0] * c2[1]; oh1[0] = ah1[0] * c2[0] + al1[0] * c2[1];
                    ol1[1] = al1[1] * c2[2] - ah1[1] * c2[3]; oh1[1] = ah1[1] * c2[2] + al1[1] * c2[3];
                    ol1[2] = al1[2] * c3[0] - ah1[2] * c3[1]; oh1[2] = ah1[2] * c3[0] + al1[2] * c3[1];
                    ol1[3] = al1[3] * c3[2] - ah1[3] * c3[3]; oh1[3] = ah1[3] * c3[2] + al1[3] * c3[3];
                    *(u32x4*)(out + (size_t)row * 1024 + colbase) = pack8(ol0 * sc, ol1 * sc);
                    *(u32x4*)(out + (size_t)row * 1024 + colbase + 32) = pack8(oh0 * sc, oh1 * sc); }
        } else if (pn < 32) {
            const bool zb = pn >= 28; const int jt = (pn - 24) & 3; bf16_t* out = zb ? ZB : V; const int col = jt * 256 + wc * 32 + 8 * fq;
#pragma unroll
            for (int ai = 0; ai < 2; ++ai)
#pragma unroll
                for (int m = 0; m < 4; ++m) { const int row = row0 + ai * HALF + m * 16;
#pragma unroll
                    for (int bj = 0; bj < 2; ++bj) { f32x4 a0 = acc[ai][bj][m][0], a1 = acc[ai][bj][m][1];
                        if (zb) {
#pragma unroll
                            for (int j = 0; j < 4; ++j) { a0[j] = silu_f(a0[j]); a1[j] = silu_f(a1[j]); } }
                        *(u32x4*)(out + (size_t)row * 1024 + col + bj * HALF) = pack8(a0, a1); } }
        } else {
            const int jt = pn - 32; const int col = jt * 128 + wc * 32 + 8 * fq;
#pragma unroll
            for (int ai = 0; ai < 2; ++ai)
#pragma unroll
                for (int m = 0; m < 4; ++m) { const int row = row0 + ai * HALF + m * 16;
                    f32x4 r0, r1, s0, s1;
#pragma unroll
                    for (int n = 0; n < 2; ++n)
#pragma unroll
                        for (int j = 0; j < 4; ++j) { const float a = acc[ai][0][m][n][j], b = acc[ai][1][m][n][j];
                            const float ea = fexp2(-a * L2E), eb = fexp2(-b * L2E); const float sb = frcp(1.0f + eb), r = frcp(1.0f + ea);
                            if (n == 0) { r0[j] = r; s0[j] = sb; } else { r1[j] = r; s1[j] = sb; } }
                    *(u32x4*)(R + (size_t)row * 2048 + col) = pack8(r0, r1);
                    *(u32x4*)(SB + (size_t)row * 2048 + col) = pack8(s0, s1); }
        }
    }
};
struct Merge1Epi {
    static constexpr bool PERM = true, AFTER_DRAIN = false;
    const bf16_t* SA; bf16_t* T;
    __device__ __forceinline__ void operator()(const f32x4 (&acc)[2][2][4][2], const Unit& u, int wr, int wc, int fr, int fq) const {
        const int row0 = u.pm * BM + wr * 64 + fr, col0 = u.pn * BM + wc * 32 + 8 * fq;
#pragma unroll
        for (int ai = 0; ai < 2; ++ai)
#pragma unroll
            for (int m = 0; m < 4; ++m) {
#pragma unroll
                for (int bj = 0; bj < 2; ++bj) { const size_t off = (size_t)(row0 + ai * HALF + m * 16) * 2048 + col0 + bj * HALF; const u32x4 w = *(const u32x4*)(SA + off);
                    *(u32x4*)(T + off) = pack8(acc[ai][bj][m][0] * (f32x4){bf_lo(w.x), bf_hi(w.x), bf_lo(w.y), bf_hi(w.y)}, acc[ai][bj][m][1] * (f32x4){bf_lo(w.z), bf_hi(w.z), bf_lo(w.w), bf_hi(w.w)}); }
                if (m & 1) asm volatile("" ::: "memory"); }
    }
};
struct Merge2Epi {
    static constexpr bool PERM = true, AFTER_DRAIN = false;
    const bf16_t* SB; const bf16_t* T; bf16_t* O;
    __device__ __forceinline__ void operator()(const f32x4 (&acc)[2][2][4][2], const Unit& u, int wr, int wc, int fr, int fq) const {
        const int row0 = u.pm * BM + wr * 64 + fr, col0 = u.pn * BM + wc * 32 + 8 * fq;
#pragma unroll
        for (int ai = 0; ai < 2; ++ai)
#pragma unroll
            for (int m = 0; m < 4; ++m) {
#pragma unroll
                for (int bj = 0; bj < 2; ++bj) { const size_t off = (size_t)(row0 + ai * HALF + m * 16) * 2048 + col0 + bj * HALF; const u32x4 w = *(const u32x4*)(SB + off);
                    const u32x4 tw = *(const u32x4*)(T + off); const f32x4 t0 = (f32x4){bf_lo(tw.x), bf_hi(tw.x), bf_lo(tw.y), bf_hi(tw.y)}, t1 = (f32x4){bf_lo(tw.z), bf_hi(tw.z), bf_lo(tw.w), bf_hi(tw.w)};
                    const f32x4 a0 = t0 + acc[ai][bj][m][0] * (f32x4){bf_lo(w.x), bf_hi(w.x), bf_lo(w.y), bf_hi(w.y)}, a1 = t1 + acc[ai][bj][m][1] * (f32x4){bf_lo(w.z), bf_hi(w.z), bf_lo(w.w), bf_hi(w.w)};
                    *(u32x4*)(O + off) = pack8(a0, a1); }
                if (m & 1) asm volatile("" ::: "memory"); }
    }
};
struct ResEpi {
    static constexpr bool PERM = false, AFTER_DRAIN = false;
    const float* xin; float* xout; const float* gate;
    __device__ __forceinline__ void operator()(const f32x4 (&acc)[2][2][4][2], const Unit& u, int wr, int wc, int fr, int fq) const {
        const int row0 = u.pm * BM + wr * 64 + fr, col0 = u.pn * BM + wc * 32 + 4 * fq;
        f32x4 gv[2][2];
#pragma unroll
        for (int bj = 0; bj < 2; ++bj)
#pragma unroll
            for (int n = 0; n < 2; ++n) gv[bj][n] = *(const f32x4*)(gate + col0 + bj * HALF + n * 16);
#pragma unroll
        for (int ai = 0; ai < 2; ++ai)
#pragma unroll
            for (int m = 0; m < 4; ++m) { const size_t off = (size_t)(row0 + ai * HALF + m * 16) * 2048 + col0;
#pragma unroll
                for (int bj = 0; bj < 2; ++bj)
#pragma unroll
                    for (int n = 0; n < 2; ++n) { const f32x4 xi = *(const f32x4*)(xin + off + bj * HALF + n * 16);
                        *(f32x4*)(xout + off + bj * HALF + n * 16) = xi + gv[bj][n] * acc[ai][bj][m][n]; } }
    }
};
template <class Epi, class Sched, bool ALIGN_EPI = false, bool SP2 = false>
__device__ __forceinline__ void gemm_phase(PG8_LAS unsigned char* lds, const Gemm g, const Sched& S, const Epi& E) {
    int tid_ = threadIdx.x; asm volatile("" : "+v"(tid_));
    const int tid = tid_, wid = __builtin_amdgcn_readfirstlane(tid >> 6), lane = tid & 63, wr = wid >> 2, wc = wid & 3, fr = lane & 15, fq = lane >> 4;
    const int K = g.K, nt = K / BK;
    unsigned voffA[2], voffB[2];
#pragma unroll
    for (int i = 0; i < 2; ++i) { int R, C; stage_rc(tid * 16 + i * 8192, R, C); const int Rb = Epi::PERM ? ((R & ~31) + perm32(R & 31)) : R;
        voffA[i] = (unsigned)(R * K + C) * 2u; voffB[i] = (unsigned)(Rb * K + C) * 2u; }
    const size_t kstep = (size_t)(BK * 2);
    const size_t hstep = (size_t)HALF * K * 2;
    const size_t tstep = 2 * hstep;
    const unsigned ldsw = (unsigned)wid * 1024u;
    const int aoff = lds_byte(wr * 64 + fr, fq * 8), boff = lds_byte(wc * 32 + fr, fq * 8);
#define PG8_SA(b, h) (((b) * 2 + (h)) * HTB)
#define PG8_SB(b, h) ((4 + (b) * 2 + (h)) * HTB)
#define PG8_STAGE(bufoff, gbase, voff) do { _Pragma("unroll") for (int _i = 0; _i < 2; ++_i) \
        __builtin_amdgcn_global_load_lds((const unsigned*)((const char*)(gbase) + (voff)[_i]), (PG8_LAS unsigned*)(lds + (bufoff) + ldsw + _i * 8192), 16, 0, 0); } while (0)
#define PG8_LDA(dst, b, h) do { _Pragma("unroll") for (int m = 0; m < 4; ++m) _Pragma("unroll") for (int k = 0; k < 2; ++k) dst[m][k] = *(const PG8_LAS bf16x8*)(lds + PG8_SA(b, h) + aoff + m * 2048 + k * 1024); } while (0)
#define PG8_LDB(dst, b, h) do { _Pragma("unroll") for (int n = 0; n < 2; ++n) _Pragma("unroll") for (int k = 0; k < 2; ++k) dst[n][k] = *(const PG8_LAS bf16x8*)(lds + PG8_SB(b, h) + boff + n * 2048 + k * 1024); } while (0)
#define PG8_MMA(ai, bj, At, Bt) do { __builtin_amdgcn_s_setprio(1); _Pragma("unroll") for (int m = 0; m < 4; ++m) _Pragma("unroll") for (int n = 0; n < 2; ++n) _Pragma("unroll") for (int k = 0; k < 2; ++k) \
        acc[ai][bj][m][n] = __builtin_amdgcn_mfma_f32_16x16x32_bf16(Bt[n][k], At[m][k], acc[ai][bj][m][n], 0, 0, 0); __builtin_amdgcn_s_setprio(0); } while (0)
#define PG8_WAIT_V(n) asm volatile("s_waitcnt vmcnt(" #n ")" ::: "memory")
#define PG8_WAIT_L(n) asm volatile("s_waitcnt lgkmcnt(" #n ")" ::: "memory")
#define PG8_BAR __builtin_amdgcn_s_barrier()
#define PG8_SCHED __builtin_amdgcn_sched_barrier(0)
    Unit cur, nxt; int ui = 0;
    if (!S.next(0, cur)) return;
    f32x4 acc[2][2][4][2];
#pragma unroll
    for (int a = 0; a < 2; ++a)
#pragma unroll
        for (int b = 0; b < 2; ++b)
#pragma unroll
            for (int m = 0; m < 4; ++m)
#pragma unroll
                for (int n = 0; n < 2; ++n) acc[a][b][m][n] = (f32x4){0.f, 0.f, 0.f, 0.f};
    bf16x8 At[4][2], B0[2][2], B1[2][2];
    const char* cA = (const char*)g.A + (size_t)cur.pm * tstep; const char* cB = (const char*)g.Bt + (size_t)cur.pn * tstep;
    S.a_ready(cur);
    if constexpr (SP2) {
        PG8_STAGE(PG8_SB(0, 0), cB, voffB); PG8_STAGE(PG8_SB(0, 1), cB + hstep, voffB); PG8_STAGE(PG8_SA(0, 0), cA, voffA); PG8_STAGE(PG8_SA(0, 1), cA + hstep, voffA);
        if (wr == 1) PG8_BAR;
        PG8_WAIT_V(2); PG8_BAR;
        PG8_STAGE(PG8_SB(1, 0), cB + kstep, voffB); PG8_STAGE(PG8_SA(1, 0), cA + kstep, voffA); PG8_STAGE(PG8_SB(1, 1), cB + hstep + kstep, voffB);
        PG8_WAIT_V(6); PG8_BAR;
    } else {
        PG8_STAGE(PG8_SB(0, 0), cB, voffB); PG8_STAGE(PG8_SA(0, 0), cA, voffA); PG8_STAGE(PG8_SB(0, 1), cB + hstep, voffB); PG8_STAGE(PG8_SA(0, 1), cA + hstep, voffA);
        if (wr == 1) PG8_BAR;
        PG8_WAIT_V(4); PG8_BAR;
        PG8_STAGE(PG8_SB(1, 0), cB + kstep, voffB); PG8_STAGE(PG8_SA(1, 0), cA + kstep, voffA); PG8_STAGE(PG8_SB(1, 1), cB + hstep + kstep, voffB);
        PG8_WAIT_V(6); PG8_BAR;
    }
    for (;;) {
        const bool has_next = S.next(ui + 1, nxt);
        const char* nA = has_next ? (const char*)g.A + (size_t)nxt.pm * tstep : cA; const char* nB = has_next ? (const char*)g.Bt + (size_t)nxt.pn * tstep : cB;
        for (int t = 0; t < nt; t += 2) {
            const bool last = (t == nt - 2);
            const char* a1 = cA + (size_t)(t + 1) * kstep;
            const char* a2 = last ? nA : cA + (size_t)(t + 2) * kstep; const char* b2 = last ? nB : cB + (size_t)(t + 2) * kstep;
            const char* a3 = a2 + kstep; const char* b3 = b2 + kstep;
            if (last && has_next) S.a_ready(nxt);
            if constexpr (SP2) {
            PG8_LDB(B0, 0, 0); PG8_LDB(B1, 0, 1); PG8_SCHED; PG8_LDA(At, 0, 0); PG8_STAGE(PG8_SA(1, 1), a1 + hstep, voffA);
            PG8_WAIT_V(8); PG8_WAIT_L(0); PG8_BAR; PG8_MMA(0, 0, At, B0); PG8_MMA(0, 1, At, B1); PG8_BAR; PG8_SCHED;
            PG8_LDA(At, 0, 1); PG8_STAGE(PG8_SB(0, 0), b2, voffB); PG8_STAGE(PG8_SB(0, 1), b2 + hstep, voffB); PG8_STAGE(PG8_SA(0, 0), a2, voffA);
            PG8_WAIT_V(8); PG8_WAIT_L(0); PG8_BAR; PG8_MMA(1, 0, At, B0); PG8_MMA(1, 1, At, B1); PG8_BAR; PG8_SCHED;
            PG8_LDB(B0, 1, 0); PG8_LDB(B1, 1, 1); PG8_SCHED; PG8_LDA(At, 1, 0); PG8_STAGE(PG8_SA(0, 1), a2 + hstep, voffA);
            PG8_WAIT_V(8); PG8_WAIT_L(0); PG8_BAR; PG8_MMA(0, 0, At, B0); PG8_MMA(0, 1, At, B1); PG8_BAR; PG8_SCHED;
            PG8_LDA(At, 1, 1); PG8_STAGE(PG8_SB(1, 0), b3, voffB); PG8_STAGE(PG8_SB(1, 1), b3 + hstep, voffB); PG8_STAGE(PG8_SA(1, 0), a3, voffA);
            PG8_WAIT_V(8); PG8_WAIT_L(0); PG8_BAR; PG8_MMA(1, 0, At, B0); PG8_MMA(1, 1, At, B1); PG8_BAR; PG8_SCHED;
            } else {
            PG8_LDB(B0, 0, 0); PG8_SCHED; PG8_LDA(At, 0, 0); PG8_STAGE(PG8_SA(1, 1), a1 + hstep, voffA);
            PG8_WAIT_L(8); PG8_BAR; PG8_WAIT_L(0); PG8_MMA(0, 0, At, B0); PG8_BAR; PG8_SCHED;
            PG8_LDB(B1, 0, 1); PG8_STAGE(PG8_SB(0, 0), b2, voffB);
            PG8_BAR; PG8_WAIT_L(0); PG8_MMA(0, 1, At, B1); PG8_BAR;
            PG8_LDA(At, 0, 1); PG8_STAGE(PG8_SA(0, 0), a2, voffA);
            PG8_BAR; PG8_WAIT_L(0); PG8_MMA(1, 0, At, B0); PG8_BAR; PG8_SCHED;
            PG8_STAGE(PG8_SB(0, 1), b2 + hstep, voffB);
            PG8_WAIT_V(6); PG8_BAR; PG8_MMA(1, 1, At, B1); PG8_BAR;
            PG8_LDB(B0, 1, 0); PG8_SCHED; PG8_LDA(At, 1, 0); PG8_STAGE(PG8_SA(0, 1), a2 + hstep, voffA);
            PG8_WAIT_L(8); PG8_BAR; PG8_WAIT_L(0); PG8_MMA(0, 0, At, B0); PG8_BAR; PG8_SCHED;
            PG8_LDB(B1, 1, 1); PG8_STAGE(PG8_SB(1, 0), b3, voffB);
            PG8_BAR; PG8_WAIT_L(0); PG8_MMA(0, 1, At, B1); PG8_BAR;
            PG8_LDA(At, 1, 1); PG8_STAGE(PG8_SA(1, 0), a3, voffA);
            PG8_BAR; PG8_WAIT_L(0); PG8_MMA(1, 0, At, B0); PG8_BAR; PG8_SCHED;
            PG8_STAGE(PG8_SB(1, 1), b3 + hstep, voffB);
            PG8_WAIT_V(6); PG8_BAR; PG8_MMA(1, 1, At, B1); PG8_BAR;
            }
        }
        if constexpr (ALIGN_EPI) { if (wr == 0) PG8_BAR; }
        if constexpr (!Epi::AFTER_DRAIN) { E(acc, cur, wr, wc, fr, fq); S.done(cur); }
        if (!has_next) break;
#pragma unroll
        for (int a = 0; a < 2; ++a)
#pragma unroll
            for (int b = 0; b < 2; ++b)
#pragma unroll
                for (int m = 0; m < 4; ++m)
#pragma unroll
                    for (int n = 0; n < 2; ++n) acc[a][b][m][n] = (f32x4){0.f, 0.f, 0.f, 0.f};
        cur = nxt; cA = nA; cB = nB; ++ui;
        if constexpr (ALIGN_EPI) { if (wr == 1) PG8_BAR; }
    }
    PG8_WAIT_V(0);
    if constexpr (!ALIGN_EPI) { if (wr == 0) PG8_BAR; }
    PG8_BAR;
    if constexpr (Epi::AFTER_DRAIN) { E.fused(acc, cur, wr, wc, fr, fq, lds, wid, lane); S.done(cur); }
#undef PG8_SA
#undef PG8_SB
#undef PG8_STAGE
#undef PG8_LDA
#undef PG8_LDB
#undef PG8_MMA
#undef PG8_WAIT_V
#undef PG8_WAIT_L
#undef PG8_BAR
#undef PG8_SCHED
}
}
constexpr int S_ = 8192, D_ = 2048, DIN = 12288, DEPTH = 4;
constexpr size_t MiB = 1u << 20;
constexpr size_t WS_CTL = 3 * MiB, CTL_BYTES = 65536;
constexpr size_t WS_MOD = 0, WS_ROPE = 1 * MiB, WS_WIN = 4 * MiB, WS_WOUT = 196 * MiB, WS_WO = 228 * MiB, WS_H = 260 * MiB, WS_Q = 292 * MiB, WS_K = 308 * MiB, WS_V = 324 * MiB,
                 WS_VG = 340 * MiB, WS_GG = 356 * MiB, WS_ZB = 372 * MiB, WS_R = 388 * MiB, WS_SB = 420 * MiB, WS_YCAT = 452 * MiB, WS_MG = 484 * MiB, WS_X = 516 * MiB, WS_T = 580 * MiB, WS_END = 644 * MiB;
constexpr int LDS_BYTES = 147456;
#define LAS __attribute__((address_space(3)))
typedef unsigned short bf16;
typedef unsigned v4u __attribute__((ext_vector_type(4)));
typedef unsigned v2u __attribute__((ext_vector_type(2)));
typedef float f32x4 __attribute__((ext_vector_type(4)));
typedef float f32x16 __attribute__((ext_vector_type(16)));
typedef short bf16x8 __attribute__((ext_vector_type(8)));
typedef short s16x4 __attribute__((ext_vector_type(4)));
using pg8::cvt_pk_bf16; using pg8::bf_lo; using pg8::bf_hi; using pg8::fexp2; using pg8::frcp; using pg8::L2E;

struct Args { const float* in[17]; float* out; unsigned char* ws; int ph_lo, ph_hi; };

__device__ __forceinline__ float wave_sum(float v) {
#pragma unroll
    for (int o = 1; o < 64; o <<= 1) v += __shfl_xor(v, o);
    return v;
}
__device__ __forceinline__ int map_in(int n0) {
    if (n0 < 4096) { const int seg = n0 >> 10, ch = n0 & 1023; const int tile = ((seg & 1) ? 8 : 0) + (ch >> 7); return tile * 256 + ((seg >> 1) ? 128 : 0) + (ch & 127); }
    if (n0 < 6144) { const int isk = n0 >= 5120, e = n0 - (isk ? 5120 : 4096), g = e >> 6, d = e & 63; return (16 + 4 * isk + (g >> 2)) * 256 + 128 * (d >> 5) + 32 * (g & 3) + (d & 31); }
    if (n0 < 8192) return n0;
    { const int isb = n0 >= 10240, j = n0 - (isb ? 10240 : 8192); return (32 + (j >> 7)) * 256 + 128 * isb + (j & 127); }
}
__device__ __forceinline__ void transpose_item(const float* W, int N, bf16* WT, int ldd, int koff, int k0, int n0, int drow0, LAS float* scr, int lane) {
    {
        f32x4 v[8]; const float* src = W + (size_t)(k0 + (lane >> 3)) * N + n0 + 4 * (lane & 7);
#pragma unroll
        for (int i = 0; i < 8; ++i) v[i] = __builtin_nontemporal_load((const f32x4*)(src + (size_t)(8 * i) * N));
#pragma unroll
        for (int i = 0; i < 8; ++i) { LAS float* d = scr + (8 * i + (lane >> 3)) * 33 + 4 * (lane & 7); d[0] = v[i].x; d[1] = v[i].y; d[2] = v[i].z; d[3] = v[i].w; }
    }
    asm volatile("s_waitcnt lgkmcnt(0)" ::: "memory");
    const int c = lane & 7;
#pragma unroll
    for (int j = 0; j < 4; ++j) { const int n = (lane >> 3) + 8 * j; const LAS float* s = scr + (8 * c) * 33 + n;
        v4u o; o.x = cvt_pk_bf16(s[0 * 33], s[1 * 33]); o.y = cvt_pk_bf16(s[2 * 33], s[3 * 33]); o.z = cvt_pk_bf16(s[4 * 33], s[5 * 33]); o.w = cvt_pk_bf16(s[6 * 33], s[7 * 33]);
        *(v4u*)(WT + (size_t)(drow0 + n) * ldd + koff + k0 + 8 * c) = o; }
    asm volatile("s_waitcnt lgkmcnt(0)" ::: "memory");
}
__device__ __forceinline__ void prologue(const Args& a, LAS unsigned char* lds, int tid, int lane, int wave) {
    unsigned char* ws = a.ws;
    if (blockIdx.x < 192 || gridDim.x < 192) {
        LAS float* cact = (LAS float*)lds; LAS float* red = (LAS float*)(lds + 8192);
        for (int i = tid; i < D_; i += 512) { const float v = a.in[1][i]; cact[i] = pg8::silu_f(v); }
        __syncthreads();
        for (int cgi = blockIdx.x; cgi < 192; cgi += gridDim.x) {
            const int l = cgi / 48, col0 = (cgi % 48) * 128 + 2 * lane;
            const float* w = a.in[2] + (size_t)l * D_ * 6144 + col0; float s0 = 0.f, s1 = 0.f;
#pragma unroll 8
            for (int k = wave * 256; k < wave * 256 + 256; ++k) { const float2 v = *(const float2*)(w + (size_t)k * 6144); const float cv = cact[k]; s0 += cv * v.x; s1 += cv * v.y; }
            red[wave * 128 + 2 * lane] = s0; red[wave * 128 + 2 * lane + 1] = s1;
            __syncthreads();
            if (tid < 128) { float s = a.in[3][l * 6144 + (cgi % 48) * 128 + tid];
#pragma unroll
                for (int w8 = 0; w8 < 8; ++w8) s += red[w8 * 128 + tid];
                ((float*)(ws + WS_MOD))[l * 6144 + (cgi % 48) * 128 + tid] = s; }
            __syncthreads();
        }
    }
    for (int e = blockIdx.x * 512 + tid; e < S_ * 32; e += gridDim.x * 512) {
        const int pos = e >> 5, i = e & 31; const float inv = exp2f(-(float)i * (13.287712379549449f / 32.0f)); const float ang = (float)pos * inv;
        const double rev = (double)ang * 0.15915494309189535; const float fr = (float)(rev - floor(rev));
        ((float2*)(ws + WS_ROPE))[e] = make_float2(__builtin_amdgcn_cosf(fr), __builtin_amdgcn_sinf(fr));
    }
    LAS float* scr = (LAS float*)(lds + wave * 16384);
    const int gw = blockIdx.x * 8 + wave, NGW = gridDim.x * 8;
    constexpr int I_IN = 32 * 384, I_C = 16 * 64, I_A = 16 * 64, I_O = 32 * 64, I_L = I_IN + I_C + I_A + I_O;
    for (int it = gw; it < DEPTH * I_L; it += NGW) {
        const int l = it / I_L; int r = it % I_L;
        if (r < I_IN) { const int kb = r / 384, nb = r % 384; transpose_item(a.in[5] + (size_t)l * D_ * DIN, DIN, (bf16*)(ws + WS_WIN) + (size_t)l * DIN * D_, D_, 0, 64 * kb, 32 * nb, map_in(32 * nb), scr, lane); continue; } r -= I_IN;
        if (r < I_C) { const int kb = r / 64, nb = r % 64; transpose_item(a.in[7] + (size_t)l * 1024 * D_, D_, (bf16*)(ws + WS_WOUT) + (size_t)l * D_ * D_, 1024, 0, 64 * kb, 32 * nb, 32 * nb, scr, lane); continue; } r -= I_C;
        if (r < I_A) { const int kb = r / 64, nb = r % 64; transpose_item(a.in[15] + (size_t)l * 1024 * D_, D_, (bf16*)(ws + WS_WOUT) + (size_t)l * D_ * D_ + (size_t)D_ * 1024, 1024, 0, 64 * kb, 32 * nb, 32 * nb, scr, lane); continue; } r -= I_A;
        { const int kb = r / 64, nb = r % 64; transpose_item(a.in[16] + (size_t)l * D_ * D_, D_, (bf16*)(ws + WS_WO) + (size_t)l * D_ * D_, D_, 0, 64 * kb, 32 * nb, 32 * nb, scr, lane); }
    }
}
__device__ __forceinline__ void norm_phase(const float* x, const float* g, const float* mod, bf16* H, int lane, int wave) {
    const int gw = blockIdx.x * 8 + wave, NGW = gridDim.x * 8;
    for (int row = gw; row < S_; row += 2 * NGW) {
        const int row2 = row + NGW; const bool has2 = row2 < S_;
        const f32x4* xr = (const f32x4*)(x + (size_t)row * D_) + lane; const f32x4* xr2 = (const f32x4*)(x + (size_t)(has2 ? row2 : row) * D_) + lane;
        f32x4 v[8], u[8]; float s = 0.f, s2 = 0.f;
#pragma unroll
        for (int j = 0; j < 8; ++j) { v[j] = xr[64 * j]; u[j] = xr2[64 * j]; }
#pragma unroll
        for (int j = 0; j < 8; ++j) { s += (v[j].x * v[j].x + v[j].y * v[j].y) + (v[j].z * v[j].z + v[j].w * v[j].w); s2 += (u[j].x * u[j].x + u[j].y * u[j].y) + (u[j].z * u[j].z + u[j].w * u[j].w); }
        const float rinv = __builtin_amdgcn_rsqf(wave_sum(s) * (1.0f / D_) + 1e-6f), rinv2 = __builtin_amdgcn_rsqf(wave_sum(s2) * (1.0f / D_) + 1e-6f);
        v2u* o8 = (v2u*)(H + (size_t)row * D_) + lane; v2u* o82 = (v2u*)(H + (size_t)row2 * D_) + lane;
#pragma unroll
        for (int j = 0; j < 8; ++j) { const int col = 4 * lane + 256 * j; const f32x4 gg = *(const f32x4*)(g + col), sh = *(const f32x4*)(mod + col), sc = *(const f32x4*)(mod + 2048 + col);
            const f32x4 gs = gg * (sc + 1.0f);
            const f32x4 y = v[j] * rinv * gs + sh; v2u w; w.x = cvt_pk_bf16(y.x, y.y); w.y = cvt_pk_bf16(y.z, y.w); o8[64 * j] = w;
            if (has2) { const f32x4 y2 = u[j] * rinv2 * gs + sh; v2u w2; w2.x = cvt_pk_bf16(y2.x, y2.y); w2.y = cvt_pk_bf16(y2.z, y2.w); o82[64 * j] = w2; } }
    }
}
__device__ __forceinline__ void conv_phase(const bf16* VG, const bf16* GG, const float* cw, bf16* YCAT, int tid) {
    for (int item = blockIdx.x * 512 + tid; item < 1024 * 128; item += gridDim.x * 512) {
        const int cgp = item & 127, rg = item >> 7, ch = cgp * 8, t0 = rg * 8;
        float w0[8], w1[8], w2[8], v0[8], v1[8];
#pragma unroll
        for (int j = 0; j < 8; ++j) { w0[j] = cw[ch + j]; w1[j] = cw[1024 + ch + j]; w2[j] = cw[2048 + ch + j]; v0[j] = 0.f; v1[j] = 0.f; }
        if (t0 > 0) { const v4u a = *(const v4u*)(VG + (size_t)(t0 - 2) * 1024 + ch), b = *(const v4u*)(VG + (size_t)(t0 - 1) * 1024 + ch);
            v0[0] = bf_lo(a.x); v0[1] = bf_hi(a.x); v0[2] = bf_lo(a.y); v0[3] = bf_hi(a.y); v0[4] = bf_lo(a.z); v0[5] = bf_hi(a.z); v0[6] = bf_lo(a.w); v0[7] = bf_hi(a.w);
            v1[0] = bf_lo(b.x); v1[1] = bf_hi(b.x); v1[2] = bf_lo(b.y); v1[3] = bf_hi(b.y); v1[4] = bf_lo(b.z); v1[5] = bf_hi(b.z); v1[6] = bf_lo(b.w); v1[7] = bf_hi(b.w); }
#pragma unroll
        for (int i = 0; i < 8; ++i) { const v4u a = *(const v4u*)(VG + (size_t)(t0 + i) * 1024 + ch), gq = *(const v4u*)(GG + (size_t)(t0 + i) * 1024 + ch);
            float v2[8], gv[8], y[8];
            v2[0] = bf_lo(a.x); v2[1] = bf_hi(a.x); v2[2] = bf_lo(a.y); v2[3] = bf_hi(a.y); v2[4] = bf_lo(a.z); v2[5] = bf_hi(a.z); v2[6] = bf_lo(a.w); v2[7] = bf_hi(a.w);
            gv[0] = bf_lo(gq.x); gv[1] = bf_hi(gq.x); gv[2] = bf_lo(gq.y); gv[3] = bf_hi(gq.y); gv[4] = bf_lo(gq.z); gv[5] = bf_hi(gq.z); gv[6] = bf_lo(gq.w); gv[7] = bf_hi(gq.w);
#pragma unroll
            for (int j = 0; j < 8; ++j) { y[j] = gv[j] * (w0[j] * v0[j] + w1[j] * v1[j] + w2[j] * v2[j]); v0[j] = v1[j]; v1[j] = v2[j]; }
            v4u o; o.x = cvt_pk_bf16(y[0], y[1]); o.y = cvt_pk_bf16(y[2], y[3]); o.z = cvt_pk_bf16(y[4], y[5]); o.w = cvt_pk_bf16(y[6], y[7]);
            *(v4u*)(YCAT + (size_t)(t0 + i) * 1024 + ch) = o; }
    }
}
namespace att {
constexpr int KS = 144, VS = 320, KT_BYTES = 2 * 64 * KS, VT_BYTES = 64 * VS, BUF = KT_BYTES + VT_BYTES;
constexpr float THR = 24.0f;
__device__ __forceinline__ int crow(int r, int hi) { return (r & 3) + 8 * (r >> 2) + 4 * hi; }
__device__ __forceinline__ s16x4 vtr(const LAS unsigned char* p) { return __builtin_bit_cast(s16x4, __builtin_amdgcn_ds_read_tr16_b64_v4i16((LAS s16x4*)p)); }
#define ATT_SB() __builtin_amdgcn_sched_barrier(0)
__device__ __forceinline__ bf16x8 pack_slab(const f32x16& p, int s2) { v4u u_; u_.x = cvt_pk_bf16(p[8 * s2], p[8 * s2 + 1]); u_.y = cvt_pk_bf16(p[8 * s2 + 2], p[8 * s2 + 3]); u_.z = cvt_pk_bf16(p[8 * s2 + 4], p[8 * s2 + 5]); u_.w = cvt_pk_bf16(p[8 * s2 + 6], p[8 * s2 + 7]); return __builtin_bit_cast(bf16x8, u_); }
__device__ __forceinline__ void unit(LAS unsigned char* lds, const bf16* Q, const bf16* K, const bf16* V, const bf16* ZB, bf16* YCAT, const float* subg, float lam, float oscale, int h, int qb, int tid_in, int lane_in, int w) {
    int tid = tid_in; asm volatile("" : "+v"(tid)); int lane = tid & 63;
    const int c = w >> 2, wq = w & 3; int r32 = lane & 31, hi = lane >> 5;
    const int q0 = 128 * qb + 32 * wq, NT = 2 * qb + 2, ntw = (q0 >> 6) + 1;
    bf16x8 qf[4];
    { const bf16* qp = Q + (size_t)(q0 + r32) * 1024 + 128 * h + 64 * c + 8 * hi;
#pragma unroll
      for (int ks = 0; ks < 4; ++ks) qf[ks] = *(const bf16x8*)(qp + 16 * ks); }
    const int key_s = tid >> 4, ch_s = tid & 15;
    const unsigned goff = (unsigned)(key_s * 1024 + ch_s * 8) * 2u;
    const char* kgb = (const char*)(K + 128 * h); const char* vgb = (const char*)(V + 128 * h);
    const int kdst = (ch_s >> 3) * 64 * KS + key_s * KS + (ch_s & 7) * 16, vdst = 2 * KT_BYTES + key_s * VS + ch_s * 16;
    v4u kr[2], vr[2];
#define ATT_LOADK(t) do { _Pragma("unroll") for (int i_ = 0; i_ < 2; ++i_) kr[i_] = *(const v4u*)(kgb + (size_t)(64 * (t) + 32 * i_) * 2048 + goff); } while (0)
#define ATT_LOADV(t) do { _Pragma("unroll") for (int i_ = 0; i_ < 2; ++i_) vr[i_] = *(const v4u*)(vgb + (size_t)(64 * (t) + 32 * i_) * 2048 + goff); } while (0)
#define ATT_STOREK(b) do { _Pragma("unroll") for (int i_ = 0; i_ < 2; ++i_) *(LAS v4u*)(lds + (b) * KT_BYTES + kdst + 32 * i_ * KS) = kr[i_]; } while (0)
#define ATT_STOREV(b) do { _Pragma("unroll") for (int i_ = 0; i_ < 2; ++i_) *(LAS v4u*)(lds + (b) * VT_BYTES + vdst + 32 * i_ * VS) = vr[i_]; } while (0)
    const int kfo = c * 64 * KS + r32 * KS + hi * 16;
    const int vfo = 2 * KT_BYTES + (4 * hi + ((lane & 15) >> 2)) * VS + (16 * ((lane >> 4) & 1) + 4 * (lane & 3)) * 2;
    ATT_LOADK(0); ATT_LOADV(0); ATT_STOREK(0); ATT_STOREV(0); ATT_LOADK(1); ATT_STOREK(1);
    f32x16 o[4];
#pragma unroll
    for (int b = 0; b < 4; ++b) o[b] = f32x16{};
    float mref = 0.f, l = 0.f; bool zero = true;
    f32x16 sa = f32x16{}, sb = f32x16{}, sc = f32x16{}, sd = f32x16{};
    __syncthreads();
    { const LAS unsigned char* kb = lds + kfo;
#pragma unroll
      for (int ks = 0; ks < 4; ++ks) { const bf16x8 a0 = *(const LAS bf16x8*)(kb + ks * 32), a1 = *(const LAS bf16x8*)(kb + 32 * KS + ks * 32);
          sa = __builtin_amdgcn_mfma_f32_32x32x16_bf16(a0, qf[ks], sa, 0, 0, 0); sb = __builtin_amdgcn_mfma_f32_32x32x16_bf16(a1, qf[ks], sb, 0, 0, 0); }
      float rm = fmaxf(sa[0], sb[0]);
#pragma unroll
      for (int r_ = 1; r_ < 16; ++r_) rm = fmaxf(rm, fmaxf(sa[r_], sb[r_]));
      rm = fmaxf(rm, __shfl_xor(rm, 32));
      if (__any(fabsf(rm) > THR)) { mref = rm; zero = false; } }
#define ATT_EXP8(P, s2) do { if (zero) { _Pragma("unroll") for (int r_ = 0; r_ < 8; ++r_) { P[8 * (s2) + r_] = fexp2(P[8 * (s2) + r_]); ls += P[8 * (s2) + r_]; } } \
        else { _Pragma("unroll") for (int r_ = 0; r_ < 8; ++r_) { P[8 * (s2) + r_] = fexp2(P[8 * (s2) + r_] - mref); ls += P[8 * (s2) + r_]; } } } while (0)
#define ATT_VRD(dst, s_) do { _Pragma("unroll") for (int b_ = 0; b_ < 4; ++b_) { const s16x4 lo_ = vtr(vb + (s_) * 16 * VS + b_ * 64), hh_ = vtr(vb + (s_) * 16 * VS + 8 * VS + b_ * 64); \
        dst[b_] = (bf16x8){lo_[0], lo_[1], lo_[2], lo_[3], hh_[0], hh_[1], hh_[2], hh_[3]}; } } while (0)
#define ATT_PV(vf, pw_) do { _Pragma("unroll") for (int b_ = 0; b_ < 4; ++b_) o[b_] = __builtin_amdgcn_mfma_f32_32x32x16_bf16(vf[b_], pw_, o[b_], 0, 0, 0); } while (0)
#define ATT_STEP(C0, C1, N0, N1, t) do { \
        __syncthreads(); \
        if ((t) + 2 < NT) ATT_LOADK((t) + 2); \
        if ((t) + 1 < NT) ATT_LOADV((t) + 1); \
        const LAS unsigned char* kb = lds + (((t) + 1) & 1) * KT_BYTES + kfo; const LAS unsigned char* vb = lds + ((t) & 1) * VT_BYTES + vfo; \
        { float rm = fmaxf(C0[0], C1[0]); \
          _Pragma("unroll") for (int r_ = 1; r_ < 16; ++r_) rm = fmaxf(rm, fmaxf(C0[r_], C1[r_])); \
          rm = fmaxf(rm, __shfl_xor(rm, 32)); \
          if (__any(rm > mref + THR)) { const float mn = fmaxf(mref, rm); const float al = fexp2(mref - mn); mref = mn; l *= al; zero = false; \
              _Pragma("unroll") for (int b_ = 0; b_ < 4; ++b_) o[b_] *= al; } } \
        bf16x8 kf[4], vfa[4]; float ls = 0.f; bf16x8 pwa; \
        _Pragma("unroll") for (int ks = 0; ks < 2; ++ks) { kf[2 * ks] = *(const LAS bf16x8*)(kb + ks * 32); kf[2 * ks + 1] = *(const LAS bf16x8*)(kb + 32 * KS + ks * 32); } \
        ATT_VRD(vfa, 0); ATT_SB(); ATT_EXP8(C0, 0); pwa = pack_slab(C0, 0); ATT_SB(); \
        N0 = __builtin_amdgcn_mfma_f32_32x32x16_bf16(kf[0], qf[0], f32x16{}, 0, 0, 0); N1 = __builtin_amdgcn_mfma_f32_32x32x16_bf16(kf[1], qf[0], f32x16{}, 0, 0, 0); \
        N0 = __builtin_amdgcn_mfma_f32_32x32x16_bf16(kf[2], qf[1], N0, 0, 0, 0); N1 = __builtin_amdgcn_mfma_f32_32x32x16_bf16(kf[3], qf[1], N1, 0, 0, 0); \
        _Pragma("unroll") for (int ks = 0; ks < 2; ++ks) { kf[2 * ks] = *(const LAS bf16x8*)(kb + (ks + 2) * 32); kf[2 * ks + 1] = *(const LAS bf16x8*)(kb + 32 * KS + (ks + 2) * 32); } \
        ATT_PV(vfa, pwa); ATT_VRD(vfa, 1); ATT_EXP8(C0, 1); pwa = pack_slab(C0, 1); ATT_SB(); \
        N0 = __builtin_amdgcn_mfma_f32_32x32x16_bf16(kf[0], qf[2], N0, 0, 0, 0); N1 = __builtin_amdgcn_mfma_f32_32x32x16_bf16(kf[1], qf[2], N1, 0, 0, 0); \
        N0 = __builtin_amdgcn_mfma_f32_32x32x16_bf16(kf[2], qf[3], N0, 0, 0, 0); N1 = __builtin_amdgcn_mfma_f32_32x32x16_bf16(kf[3], qf[3], N1, 0, 0, 0); \
        ATT_PV(vfa, pwa); ATT_VRD(vfa, 2); ATT_EXP8(C1, 0); pwa = pack_slab(C1, 0); ATT_SB(); \
        ATT_PV(vfa, pwa); ATT_VRD(vfa, 3); ATT_EXP8(C1, 1); pwa = pack_slab(C1, 1); ATT_SB(); \
        ATT_PV(vfa, pwa); l += ls; \
        if ((t) + 1 >= ntw) { asm volatile("" ::: "memory"); _Pragma("unroll") for (int r_ = 0; r_ < 16; ++r_) { N0[r_] = -1e30f; N1[r_] = -1e30f; } } \
        if ((t) + 2 < NT) ATT_STOREK((t) & 1); \
        if ((t) + 1 < NT) ATT_STOREV(((t) + 1) & 1); \
    } while (0)
    for (int t = 0; t < NT; t += 2) { ATT_STEP(sa, sb, sc, sd, t); ATT_STEP(sc, sd, sa, sb, t + 1); }
#undef ATT_LOADK
#undef ATT_LOADV
#undef ATT_STOREK
#undef ATT_STOREV
#undef ATT_EXP8
#undef ATT_VRD
#undef ATT_PV
#undef ATT_STEP
    __syncthreads();
    l += __shfl_xor(l, 32); const float inv = 1.0f / l;
    { int t2 = tid_in; asm volatile("" : "+v"(t2)); lane = t2 & 63; r32 = lane & 31; hi = lane >> 5; }
    LAS float* ex = (LAS float*)lds + wq * 4096;
    if (c == 1) {
#pragma unroll
        for (int b = 0; b < 4; ++b)
#pragma unroll
            for (int r = 0; r < 16; ++r) ex[(32 * b + crow(r, hi)) * 32 + r32] = o[b][r] * inv;
    }
    __syncthreads();
    if (c == 0) {
        float ss = 0.f;
#pragma unroll
        for (int b = 0; b < 4; ++b)
#pragma unroll
            for (int r = 0; r < 16; ++r) { const float v = o[b][r] * inv - lam * ex[(32 * b + crow(r, hi)) * 32 + r32]; o[b][r] = v; ss += v * v; }
        ss += __shfl_xor(ss, 32);
        const float rn = __builtin_amdgcn_rsqf(ss * (1.0f / 128.0f) + 1e-6f) * oscale;
        const int row = q0 + r32;
#pragma unroll
        for (int b = 0; b < 4; ++b)
#pragma unroll
            for (int g = 0; g < 4; ++g) { const int dv = 32 * b + 8 * g + 4 * hi;
                const v2u z = *(const v2u*)(ZB + (size_t)row * 1024 + 128 * h + dv); const f32x4 sg = *(const f32x4*)(subg + dv);
                v2u wv; wv.x = cvt_pk_bf16(o[b][4 * g] * rn * sg.x * bf_lo(z.x), o[b][4 * g + 1] * rn * sg.y * bf_hi(z.x)); wv.y = cvt_pk_bf16(o[b][4 * g + 2] * rn * sg.z * bf_lo(z.y), o[b][4 * g + 3] * rn * sg.w * bf_hi(z.y));
                *(v2u*)(YCAT + (size_t)S_ * 1024 + (size_t)row * 1024 + 128 * h + dv) = wv; }
    }
    __syncthreads();
}
}

#define XB_TMO      128
#define XB_XCNT(j)  (256  + 64 * (j))
#define XB_XSUB(j)  (1280 + 64 * (j))
#define XB_XGEN(j)  (2304 + 64 * (j))
#define XB_TOP      3328
#define XB_TOPGEN   3392
#define XCD_BAR_WORDS 3456
#define XB_SPIN_CAP (1u << 18)

__device__ __forceinline__ unsigned xb_ld(unsigned* p)              { return __hip_atomic_load(p, __ATOMIC_RELAXED, __HIP_MEMORY_SCOPE_AGENT); }
__device__ __forceinline__ unsigned xb_add(unsigned* p, unsigned v) { return __hip_atomic_fetch_add(p, v, __ATOMIC_RELAXED, __HIP_MEMORY_SCOPE_AGENT); }
__device__ __forceinline__ unsigned xb_xcc_id() { return (unsigned)__builtin_amdgcn_s_getreg((3 << 11) | 20) & 0xFu; }
#define XB_SPIN(cond, bar) do { unsigned _sp = 0; while (cond) { __builtin_amdgcn_s_sleep(1); \
    if ((++_sp & 255u) == 0u) { if (xb_ld(&(bar)[XB_TMO])) break; if (_sp > XB_SPIN_CAP) { atomicAdd(&(bar)[XB_TMO], 1u); break; } } } } while (0)

struct XcdBarrier {
    unsigned* bar; unsigned x;
    volatile LAS unsigned* st;
};

__device__ __forceinline__ XcdBarrier xcd_barrier_post(unsigned* bar, volatile LAS unsigned* st) {
    XcdBarrier b; b.bar = bar; b.x = xb_xcc_id(); b.st = st;
    if (threadIdx.x == 0) (void)xb_add(&bar[XB_XCNT(b.x)], 1u);
    return b;
}
__device__ __forceinline__ void xcd_barrier_complete(unsigned* bar, unsigned x, unsigned& nloc, unsigned& nx) {
    const unsigned G = gridDim.x * gridDim.y * gridDim.z;
    unsigned sum, cnt, mine, sp = 0u;
    for (;;) {
        sum = 0u; cnt = 0u; mine = 0u;
#pragma unroll
        for (unsigned j = 0; j < 16; ++j) { const unsigned c = xb_ld(&bar[XB_XCNT(j)]); sum += c; cnt += (c > 0u) ? 1u : 0u; mine = (j == x) ? c : mine; }
        if (sum == G) break;
        __builtin_amdgcn_s_sleep(1);
        if ((++sp & 255u) == 0u) { if (xb_ld(&bar[XB_TMO])) break; if (sp > XB_SPIN_CAP) { atomicAdd(&bar[XB_TMO], 1u); break; } }
    }
    nloc = mine > 0u ? mine : 1u; nx = cnt > 0u ? cnt : 1u;
}

__device__ __forceinline__ void xcd_barrier(const XcdBarrier& b) {
    asm volatile("s_waitcnt vmcnt(0)" ::: "memory");
    __syncthreads();
    if (threadIdx.x == 0) {
        unsigned* bar = b.bar;
        __builtin_amdgcn_s_waitcnt(0);
        unsigned nloc = b.st[0], nx = b.st[1];
        if (nloc == 0u) { xcd_barrier_complete(bar, b.x, nloc, nx); b.st[0] = nloc; b.st[1] = nx; }
        const unsigned old = xb_add(&bar[XB_XSUB(b.x)], 1u);
        const unsigned gen = old / nloc;
        if (old + 1u == (gen + 1u) * nloc) {
            __builtin_amdgcn_fence(__ATOMIC_RELEASE, "agent");
            asm volatile("s_waitcnt vmcnt(0)" ::: "memory");
            const unsigned og = xb_add(&bar[XB_TOP], 1u);
            const unsigned tg = og / nx;
            if (og + 1u == (tg + 1u) * nx) xb_add(&bar[XB_TOPGEN], 1u);
            else XB_SPIN(xb_ld(&bar[XB_TOPGEN]) == tg, bar);
            __builtin_amdgcn_fence(__ATOMIC_ACQUIRE, "agent");
            xb_add(&bar[XB_XGEN(b.x)], 1u);
            asm volatile("s_waitcnt vmcnt(0)" ::: "memory");
        } else {
            XB_SPIN(xb_ld(&bar[XB_XGEN(b.x)]) == gen, bar);
            __builtin_amdgcn_fence(__ATOMIC_ACQUIRE, "agent");
            asm volatile("s_waitcnt vmcnt(0)" ::: "memory");
        }
    }
    __syncthreads();
}

__global__ void __launch_bounds__(512, 2) mega_fwd(Args args) {
    extern __shared__ __attribute__((aligned(16))) unsigned char lds_raw[];
    LAS unsigned char* lds = (LAS unsigned char*)lds_raw;
    int tid = threadIdx.x, lane = tid & 63, wave = __builtin_amdgcn_readfirstlane(tid >> 6);
#define RELAUNDER() do { tid = threadIdx.x; asm volatile("" : "+v"(tid)); lane = tid & 63; wave = __builtin_amdgcn_readfirstlane(tid >> 6); } while (0)
    unsigned char* ws = args.ws;
    const int lo = args.ph_lo, hi = args.ph_hi;
    volatile LAS unsigned* bst = (volatile LAS unsigned*)(lds + 131072 + 32);
    if (tid < 2) bst[tid] = 0u;
    __syncthreads();
    XcdBarrier bar = xcd_barrier_post((unsigned*)(ws + WS_CTL), bst);
#define IN(k) (lo <= (k) && (k) < hi)
#define SEAM(k) do { if (IN(k) && IN((k) + 1)) { if ((k) == 0) cg::this_grid().sync(); else xcd_barrier(bar); } } while (0)
    if (IN(0)) {
#ifndef NO_PRO
 for (int rep_ = 0; rep_ < REP_PRO; ++rep_) { prologue(args, lds, tid, lane, wave); __syncthreads(); }
#endif
 }
    SEAM(0);
    bf16* Hb = (bf16*)(ws + WS_H); bf16* Qb = (bf16*)(ws + WS_Q); bf16* Kb = (bf16*)(ws + WS_K); bf16* Vb = (bf16*)(ws + WS_V); bf16* VG = (bf16*)(ws + WS_VG); bf16* GG = (bf16*)(ws + WS_GG);
    bf16* ZB = (bf16*)(ws + WS_ZB); bf16* Rb = (bf16*)(ws + WS_R); bf16* SBb = (bf16*)(ws + WS_SB); bf16* YC = (bf16*)(ws + WS_YCAT); bf16* MG = (bf16*)(ws + WS_MG); float* XW = (float*)(ws + WS_X);
    for (int l = 0; l < DEPTH; ++l) {
        const int pb = 1 + 5 * l;
        const float* mod = (const float*)(ws + WS_MOD) + l * 6144;
        const float* xin = (l == 0) ? args.in[0] : XW; float* xout = (l == DEPTH - 1) ? args.out : XW;
#ifndef NO_NORM
        RELAUNDER();
        if (IN(pb)) for (int rep_ = 0; rep_ < REP_NORM; ++rep_) norm_phase(xin, args.in[4] + l * D_, mod, Hb, lane, wave);
#endif
        SEAM(pb);
        if (IN(pb + 1)) {
            pg8::Gemm g{Hb, (const bf16*)(ws + WS_WIN) + (size_t)l * DIN * D_, S_, DIN, D_}; pg8::StaticOrder S; S.init(S_, DIN, gridDim.x, (int)blockIdx.x);
            pg8::InProjEpi E{Qb, Kb, Vb, VG, GG, ZB, Rb, SBb, args.in[8] + l * 64, args.in[9] + l * 64, (const float*)(ws + WS_ROPE), 0.125f * L2E};
#ifndef NO_INPROJ
            for (int rep_ = 0; rep_ < REP_INPROJ; ++rep_) pg8::gemm_phase<pg8::InProjEpi, pg8::StaticOrder, true, true>(lds, g, S, E);
#endif
        }
        SEAM(pb + 1);
        if (IN(pb + 2)) { RELAUNDER();
#ifndef NO_CONV
            conv_phase(VG, GG, args.in[6] + l * 3 * 1024, YC, tid);
#endif
            const float s1 = wave_sum(args.in[10][l * 64 + lane] * args.in[11][l * 64 + lane]), s2 = wave_sum(args.in[12][l * 64 + lane] * args.in[13][l * 64 + lane]);
            const float linit = 0.8f - 0.6f * expf(-0.3f * (float)l); const float lam = expf(s1) - expf(s2) + linit;
#ifndef NO_ATT
            for (int rep_ = 0; rep_ < REP_ATT; ++rep_)
            for (int pr = blockIdx.x; pr < 256; pr += gridDim.x) { const int h = pr & 7, pi = pr >> 3;
                att::unit(lds, Qb, Kb, Vb, ZB, YC, args.in[14] + l * 128, lam, 1.0f - linit, h, 63 - pi, tid, lane, wave);
                att::unit(lds, Qb, Kb, Vb, ZB, YC, args.in[14] + l * 128, lam, 1.0f - linit, h, pi, tid, lane, wave); }
#endif
        }
        SEAM(pb + 2);
        if (IN(pb + 3)) {
            pg8::StaticOrder S; S.init(S_, D_, gridDim.x, (int)blockIdx.x); bf16* Tb = (bf16*)(ws + WS_T);
#ifndef NO_MERGE
            for (int rep_ = 0; rep_ < REP_MERGE; ++rep_) {
            { pg8::Gemm g{YC, (const bf16*)(ws + WS_WOUT) + (size_t)l * D_ * D_, S_, D_, 1024}; pg8::Merge1Epi E{Rb, Tb};
              pg8::gemm_phase<pg8::Merge1Epi, pg8::StaticOrder, true, true>(lds, g, S, E); }
            { pg8::Gemm g{YC + (size_t)S_ * 1024, (const bf16*)(ws + WS_WOUT) + (size_t)l * D_ * D_ + (size_t)D_ * 1024, S_, D_, 1024}; pg8::Merge2Epi E{SBb, Tb, MG};
              pg8::gemm_phase<pg8::Merge2Epi, pg8::StaticOrder, true, true>(lds, g, S, E); }
            }
#endif
        }
        SEAM(pb + 3);
        if (IN(pb + 4)) {
            pg8::Gemm g{MG, (const bf16*)(ws + WS_WO) + (size_t)l * D_ * D_, S_, D_, D_}; pg8::StaticOrder S; S.init(S_, D_, gridDim.x, (int)blockIdx.x);
            pg8::ResEpi E{xin, xout, mod + 4096};
#ifndef NO_RES
            pg8::gemm_phase<pg8::ResEpi, pg8::StaticOrder, true, true>(lds, g, S, E);
#endif
        }
        SEAM(pb + 4);
    }
#undef IN
#undef SEAM
}
constexpr int N_PHASES = 1 + 5 * DEPTH;

extern "C" void kernel_launch(void* const* d_in, const int* in_sizes, int n_in, void* d_out, int out_size, void* d_ws, size_t ws_size, hipStream_t stream) {
    static int grid = 0;
    if (grid == 0) {
        if (n_in != 17 || out_size != S_ * D_ || ws_size < WS_END) { fprintf(stderr, "kernel_launch: unexpected shapes (n_in %d out %d ws %zu)\n", n_in, out_size, ws_size); grid = -1; return; }
        int dev = 0, cus = 0, per_cu = 0;
        hipGetDevice(&dev); hipDeviceGetAttribute(&cus, hipDeviceAttributeMultiprocessorCount, dev);
        if (hipFuncSetAttribute((const void*)mega_fwd, hipFuncAttributeMaxDynamicSharedMemorySize, LDS_BYTES) != hipSuccess) { fprintf(stderr, "kernel_launch: hipFuncSetAttribute failed\n"); grid = -1; return; }
        if (hipOccupancyMaxActiveBlocksPerMultiprocessor(&per_cu, (const void*)mega_fwd, 512, LDS_BYTES) != hipSuccess || per_cu < 1) { fprintf(stderr, "kernel_launch: occupancy query says %d\n", per_cu); per_cu = 1; }
        (void)hipGetLastError();
        grid = cus * 1;
        if (grid > 256) grid = 256;
    }
    if (grid < 0) return;
    if (hipMemsetAsync((char*)d_ws + WS_CTL, 0, CTL_BYTES, stream) != hipSuccess) { fprintf(stderr, "kernel_launch: memset failed\n"); return; }
    Args a{};
    for (int i = 0; i < 17; ++i) a.in[i] = (const float*)d_in[i];
    a.out = (float*)d_out; a.ws = (unsigned char*)d_ws;
#if MK_MULTI
    for (int p = 0; p < N_PHASES; ++p) { a.ph_lo = p; a.ph_hi = p + 1; hipLaunchKernelGGL(mega_fwd, dim3(grid), dim3(512), LDS_BYTES, stream, a); }
#else
    a.ph_lo = 0; a.ph_hi = N_PHASES;
    void* kargs[] = {&a};
    hipError_t e = hipLaunchCooperativeKernel((const void*)mega_fwd, dim3(grid), dim3(512), kargs, LDS_BYTES, stream);
    if (e != hipSuccess) fprintf(stderr, "cooperative launch failed: %s (grid %d)\n", hipGetErrorString(e), grid);
#endif
}
```

```cpp
#include <hip/hip_runtime.h>
#include <hip/hip_cooperative_groups.h>
#include <cstdio>
#include <cstdint>
namespace cg = cooperative_groups;
#ifndef REP_PRO
#define REP_PRO 1
#endif
#ifndef REP_NORM
#define REP_NORM 1
#endif
#ifndef REP_INPROJ
#define REP_INPROJ 1
#endif
#ifndef REP_ATT
#define REP_ATT 1
#endif
#ifndef REP_MERGE
#define REP_MERGE 1
#endif
#ifndef MK_MULTI
#define MK_MULTI 0
#endif
namespace pg8 {
#define PG8_LAS __attribute__((address_space(3)))
typedef unsigned short bf16_t;
typedef short bf16x8 __attribute__((ext_vector_type(8)));
typedef float f32x4 __attribute__((ext_vector_type(4)));
typedef unsigned u32x4 __attribute__((ext_vector_type(4)));
constexpr int BM = 256, BK = 64, HALF = 128, HTB = HALF * BK * 2  , STAGE_BYTES = 8 * HTB, NXCD = 8, WGM = 8;

__host__ __device__ __forceinline__ int lds_byte(int r, int c) { const int st = (r >> 4) * 2 + (c >> 5), rr = r & 15, cc = c & 31, ob = rr * 64 + cc * 2; return st * 1024 + (ob ^ (((ob >> 9) & 1) << 5)); }
__host__ __device__ __forceinline__ void stage_rc(int b, int& R, int& C) { const int st = b / 1024, sb = b % 1024, swz = sb ^ (((sb >> 9) & 1) << 5); R = (st >> 1) * 16 + swz / 64; C = (st & 1) * 32 + (swz % 64) / 2; }
__host__ __device__ __forceinline__ int perm32(int rho) { const int n = rho >> 4, i = rho & 15; return 8 * (i >> 2) + 4 * n + (i & 3); }

struct Unit { int pm, pn; };
struct Gemm { const bf16_t* A; const bf16_t* Bt; int M, N, K; };

struct StaticOrder {
    int nM, nN, nwg, G, c;
    __host__ __device__ void init(int M, int N, int G_, int c_) { nM = M / BM; nN = N / BM; nwg = nM * nN; G = G_; c = c_; }
    __host__ __device__ bool next(int i, Unit& u) const {
        const long L = (long)i * G + c; if (L >= nwg) return false;
        int wgid = (int)L; { const int q = nwg / NXCD, r = nwg % NXCD, xcd = wgid % NXCD, off = wgid / NXCD; wgid = (xcd < r ? xcd * (q + 1) : r * (q + 1) + (xcd - r) * q) + off; }
        const int nig = WGM * nN, gid = wgid / nig, fm = gid * WGM, gsz = (nM - fm) < WGM ? (nM - fm) : WGM;
        u.pm = fm + ((wgid % nig) % gsz); u.pn = (wgid % nig) / gsz; return true;
    }
    __device__ __forceinline__ void a_ready(const Unit&) const {}
    __device__ __forceinline__ void done(const Unit&) const {}
};

__device__ __forceinline__ unsigned cvt_pk_bf16(float lo, float hi) { unsigned r; asm volatile("v_cvt_pk_bf16_f32 %0, %1, %2" : "=v"(r) : "v"(lo), "v"(hi)); return r; }
template <int MASK> __device__ __forceinline__ float swz_xor(float v) { static_assert(MASK > 0 && MASK < 32, "ds_swizzle bit mode"); return __int_as_float(__builtin_amdgcn_ds_swizzle(__float_as_int(v), (MASK << 10) | 0x1f)); }
__device__ __forceinline__ float sum_x32(float v) { auto r = __builtin_amdgcn_permlane32_swap(__float_as_uint(v), __float_as_uint(v), false, false); return __uint_as_float(r[0]) + __uint_as_float(r[1]); }
__device__ __forceinline__ float max_x32(float v) { auto r = __builtin_amdgcn_permlane32_swap(__float_as_uint(v), __float_as_uint(v), false, false); return fmaxf(__uint_as_float(r[0]), __uint_as_float(r[1])); }
__device__ __forceinline__ float bf_lo(unsigned w) { return __uint_as_float(w << 16); }
__device__ __forceinline__ float bf_hi(unsigned w) { return __uint_as_float(w & 0xffff0000u); }
__device__ __forceinline__ float fexp2(float x) { return __builtin_amdgcn_exp2f(x); }
__device__ __forceinline__ float frcp(float x) { return __builtin_amdgcn_rcpf(x); }
constexpr float L2E = 1.4426950408889634f;
__device__ __forceinline__ float silu_f(float x) { return x * frcp(1.0f + fexp2(-x * L2E)); }
__device__ __forceinline__ u32x4 pack8(const f32x4 a, const f32x4 b) { u32x4 w; w.x = cvt_pk_bf16(a[0], a[1]); w.y = cvt_pk_bf16(a[2], a[3]); w.z = cvt_pk_bf16(b[0], b[1]); w.w = cvt_pk_bf16(b[2], b[3]); return w; }

struct InProjEpi {
    static constexpr bool PERM = true, AFTER_DRAIN = false;
    bf16_t *Q, *Kb, *V, *VG, *GG, *ZB, *R, *SB; const float* qg; const float* kg; const float* rope; float qscale;
    __device__ __forceinline__ void operator()(const f32x4 (&acc)[2][2][4][2], const Unit& u, int wr, int wc, int fr, int fq) const {
        const int pn = u.pn; const int row0 = u.pm * BM + wr * 64 + fr;
        if (pn < 16) {
            const bool bz = pn >= 8; const int jt = pn & 7; bf16_t* out = bz ? GG : VG; const int col = jt * 128 + wc * 32 + 8 * fq;
#pragma unroll
            for (int ai = 0; ai < 2; ++ai)
#pragma unroll
                for (int m = 0; m < 4; ++m) { const int row = row0 + ai * HALF + m * 16;
                    f32x4 a0 = acc[ai][0][m][0], a1 = acc[ai][0][m][1], b0 = acc[ai][1][m][0], b1 = acc[ai][1][m][1];
                    if (bz) {
#pragma unroll
                        for (int j = 0; j < 4; ++j) { b0[j] = silu_f(b0[j]); b1[j] = silu_f(b1[j]); } }
                    *(u32x4*)(out + (size_t)row * 1024 + col) = pack8(a0 * b0, a1 * b1); }
        } else if (pn < 24) {
            const bool isk = pn >= 20; const int jt = (pn - 16) & 3; const float* gw = isk ? kg : qg; bf16_t* out = isk ? Kb : Q;
            const int d0 = 8 * fq; const int colbase = 64 * (4 * jt + wc) + d0; const float sc = isk ? 1.0f : qscale;
            const f32x4 gl0 = *(const f32x4*)(gw + d0), gl1 = *(const f32x4*)(gw + d0 + 4), gh0 = *(const f32x4*)(gw + 32 + d0), gh1 = *(const f32x4*)(gw + 32 + d0 + 4);
#pragma unroll
            for (int ai = 0; ai < 2; ++ai)
#pragma unroll
                for (int m = 0; m < 4; ++m) { const int row = row0 + ai * HALF + m * 16;
                    const f32x4 xl0 = acc[ai][0][m][0], xl1 = acc[ai][0][m][1], xh0 = acc[ai][1][m][0], xh1 = acc[ai][1][m][1];
                    float ss = 0.f;
#pragma unroll
                    for (int j = 0; j < 4; ++j) ss += xl0[j] * xl0[j] + xl1[j] * xl1[j] + xh0[j] * xh0[j] + xh1[j] * xh1[j];
                    ss += swz_xor<16>(ss); ss = sum_x32(ss);
                    const float rn = __builtin_amdgcn_rsqf(ss * (1.0f / 64.0f) + 1e-6f);
                    const f32x4* rp = (const f32x4*)(rope + ((size_t)row * 32 + d0) * 2);
                    const f32x4 c0 = rp[0], c1 = rp[1], c2 = rp[2], c3 = rp[3];
                    const f32x4 al0 = xl0 * rn * gl0, al1 = xl1 * rn * gl1, ah0 = xh0 * rn * gh0, ah1 = xh1 * rn * gh1;
                    f32x4 ol0, ol1, oh0, oh1;
                    ol0[0] = al0[0] * c0[0] - ah0[0] * c0[1]; oh0[0] = ah0[0] * c0[0] + al0[0] * c0[1];
                    ol0[1] = al0[1] * c0[2] - ah0[1] * c0[3]; oh0[1] = ah0[1] * c0[2] + al0[1] * c0[3];
                    ol0[2] = al0[2] * c1[0] - ah0[2] * c1[1]; oh0[2] = ah0[2] * c1[0] + al0[2] * c1[1];
                    ol0[3] = al0[3] * c1[2] - ah0[3] * c1[3]; oh0[3] = ah0[3] * c1[2] + al0[3] * c1[3];
                    ol1[0] = al1[0] * c2[0] - ah1[0] * c2[1]; oh1[0] = ah1[0] * c2[0] + al1[0] * c2[1];
                    ol1[1] = al1[1] * c2[2] - ah1[1] * c2[3]; oh1[1] = ah1[1] * c2[2] + al1[1] * c2[3];
                    ol1[2] = al1[2] * c3[0] - ah1[2] * c3[1]; oh1[2] = ah1[2] * c3[0] + al1[2] * c3[1];
                    ol1[3] = al1[3] * c3[2] - ah1[3] * c3[3]; oh1[3] = ah1[3] * c3[2] + al1[3] * c3[3];
                    *(u32x4*)(out + (size_t)row * 1024 + colbase) = pack8(ol0 * sc, ol1 * sc);
                    *(u32x4*)(out + (size_t)row * 1024 + colbase + 32) = pack8(oh0 * sc, oh1 * sc); }
        } else if (pn < 32) {
            const bool zb = pn >= 28; const int jt = (pn - 24) & 3; bf16_t* out = zb ? ZB : V; const int col = jt * 256 + wc * 32 + 8 * fq;
#pragma unroll
            for (int ai = 0; ai < 2; ++ai)
#pragma unroll
                for (int m = 0; m < 4; ++m) { const int row = row0 + ai * HALF + m * 16;
#pragma unroll
                    for (int bj = 0; bj < 2; ++bj) { f32x4 a0 = acc[ai][bj][m][0], a1 = acc[ai][bj][m][1];
                        if (zb) {
#pragma unroll
                            for (int j = 0; j < 4; ++j) { a0[j] = silu_f(a0[j]); a1[j] = silu_f(a1[j]); } }
                        *(u32x4*)(out + (size_t)row * 1024 + col + bj * HALF) = pack8(a0, a1); } }
        } else {
            const int jt = pn - 32; const int col = jt * 128 + wc * 32 + 8 * fq;
#pragma unroll
            for (int ai = 0; ai < 2; ++ai)
#pragma unroll
                for (int m = 0; m < 4; ++m) { const int row = row0 + ai * HALF + m * 16;
                    f32x4 r0, r1, s0, s1;
#pragma unroll
                    for (int n = 0; n < 2; ++n)
#pragma unroll
                        for (int j = 0; j < 4; ++j) { const float a = acc[ai][0][m][n][j], b = acc[ai][1][m][n][j];
                            const float ea = fexp2(-a * L2E), eb = fexp2(-b * L2E); const float sb = frcp(1.0f + eb), r = frcp(1.0f + ea);
                            if (n == 0) { r0[j] = r; s0[j] = sb; } else { r1[j] = r; s1[j] = sb; } }
                    *(u32x4*)(R + (size_t)row * 2048 + col) = pack8(r0, r1);
                    *(u32x4*)(SB + (size_t)row * 2048 + col) = pack8(s0, s1); }
        }
    }
};
struct Merge1Epi {
    static constexpr bool PERM = true, AFTER_DRAIN = false;
    const bf16_t* SA; bf16_t* T;
    __device__ __forceinline__ void operator()(const f32x4 (&acc)[2][2][4][2], const Unit& u, int wr, int wc, int fr, int fq) const {
        const int row0 = u.pm * BM + wr * 64 + fr, col0 = u.pn * BM + wc * 32 + 8 * fq;
#pragma unroll
        for (int ai = 0; ai < 2; ++ai)
#pragma unroll
            for (int m = 0; m < 4; ++m) {
#pragma unroll
                for (int bj = 0; bj < 2; ++bj) { const size_t off = (size_t)(row0 + ai * HALF + m * 16) * 2048 + col0 + bj * HALF; const u32x4 w = *(const u32x4*)(SA + off);
                    *(u32x4*)(T + off) = pack8(acc[ai][bj][m][0] * (f32x4){bf_lo(w.x), bf_hi(w.x), bf_lo(w.y), bf_hi(w.y)}, acc[ai][bj][m][1] * (f32x4){bf_lo(w.z), bf_hi(w.z), bf_lo(w.w), bf_hi(w.w)}); }
                if (m & 1) asm volatile("" ::: "memory"); }
    }
};
struct Merge2Epi {
    static constexpr bool PERM = true, AFTER_DRAIN = false;
    const bf16_t* SB; const bf16_t* T; bf16_t* O;
    __device__ __forceinline__ void operator()(const f32x4 (&acc)[2][2][4][2], const Unit& u, int wr, int wc, int fr, int fq) const {
        const int row0 = u.pm * BM + wr * 64 + fr, col0 = u.pn * BM + wc * 32 + 8 * fq;
#pragma unroll
        for (int ai = 0; ai < 2; ++ai)
#pragma unroll
            for (int m = 0; m < 4; ++m) {
#pragma unroll
                for (int bj = 0; bj < 2; ++bj) { const size_t off = (size_t)(row0 + ai * HALF + m * 16) * 2048 + col0 + bj * HALF; const u32x4 w = *(const u32x4*)(SB + off);
                    const u32x4 tw = *(const u32x4*)(T + off); const f32x4 t0 = (f32x4){bf_lo(tw.x), bf_hi(tw.x), bf_lo(tw.y), bf_hi(tw.y)}, t1 = (f32x4){bf_lo(tw.z), bf_hi(tw.z), bf_lo(tw.w), bf_hi(tw.w)};
                    const f32x4 a0 = t0 + acc[ai][bj][m][0] * (f32x4){bf_lo(w.x), bf_hi(w.x), bf_lo(w.y), bf_hi(w.y)}, a1 = t1 + acc[ai][bj][m][1] * (f32x4){bf_lo(w.z), bf_hi(w.z), bf_lo(w.w), bf_hi(w.w)};
                    *(u32x4*)(O + off) = pack8(a0, a1); }
                if (m & 1) asm volatile("" ::: "memory"); }
    }
};
struct ResEpi {
    static constexpr bool PERM = false, AFTER_DRAIN = false;
    const float* xin; float* xout; const float* gate;
    __device__ __forceinline__ void operator()(const f32x4 (&acc)[2][2][4][2], const Unit& u, int wr, int wc, int fr, int fq) const {
        const int row0 = u.pm * BM + wr * 64 + fr, col0 = u.pn * BM + wc * 32 + 4 * fq;
        f32x4 gv[2][2];
#pragma unroll
        for (int bj = 0; bj < 2; ++bj)
#pragma unroll
            for (int n = 0; n < 2; ++n) gv[bj][n] = *(const f32x4*)(gate + col0 + bj * HALF + n * 16);
#pragma unroll
        for (int ai = 0; ai < 2; ++ai)
#pragma unroll
            for (int m = 0; m < 4; ++m) { const size_t off = (size_t)(row0 + ai * HALF + m * 16) * 2048 + col0;
#pragma unroll
                for (int bj = 0; bj < 2; ++bj)
#pragma unroll
                    for (int n = 0; n < 2; ++n) { const f32x4 xi = *(const f32x4*)(xin + off + bj * HALF + n * 16);
                        *(f32x4*)(xout + off + bj * HALF + n * 16) = xi + gv[bj][n] * acc[ai][bj][m][n]; } }
    }
};
template <class Epi, class Sched, bool ALIGN_EPI = false, bool SP2 = false>
__device__ __forceinline__ void gemm_phase(PG8_LAS unsigned char* lds, const Gemm g, const Sched& S, const Epi& E, int wave_sgpr) {
    int tid_ = wave_sgpr * 64 + (int)__builtin_amdgcn_mbcnt_hi(~0u, __builtin_amdgcn_mbcnt_lo(~0u, 0u)); asm volatile("" : "+v"(tid_));
    const int tid = tid_, wid = __builtin_amdgcn_readfirstlane(tid >> 6), lane = tid & 63, wr = wid >> 2, wc = wid & 3, fr = lane & 15, fq = lane >> 4;
    const int K = g.K, nt = K / BK;
    unsigned voffA[2], voffB[2];
#pragma unroll
    for (int i = 0; i < 2; ++i) { int R, C; stage_rc(tid * 16 + i * 8192, R, C); const int Rb = Epi::PERM ? ((R & ~31) + perm32(R & 31)) : R;
        voffA[i] = (unsigned)(R * K + C) * 2u; voffB[i] = (unsigned)(Rb * K + C) * 2u; }
    const size_t kstep = (size_t)(BK * 2);
    const size_t hstep = (size_t)HALF * K * 2;
    const size_t tstep = 2 * hstep;
    const unsigned ldsw = (unsigned)wid * 1024u;
    const int aoff = lds_byte(wr * 64 + fr, fq * 8), boff = lds_byte(wc * 32 + fr, fq * 8);
#define PG8_SA(b, h) (((b) * 2 + (h)) * HTB)
#define PG8_SB(b, h) ((4 + (b) * 2 + (h)) * HTB)
#define PG8_STAGE(bufoff, gbase, voff) do { _Pragma("unroll") for (int _i = 0; _i < 2; ++_i) \
        __builtin_amdgcn_global_load_lds((const unsigned*)((const char*)(gbase) + (voff)[_i]), (PG8_LAS unsigned*)(lds + (bufoff) + ldsw + _i * 8192), 16, 0, 0); } while (0)
#define PG8_LDA(dst, b, h) do { _Pragma("unroll") for (int m = 0; m < 4; ++m) _Pragma("unroll") for (int k = 0; k < 2; ++k) dst[m][k] = *(const PG8_LAS bf16x8*)(lds + PG8_SA(b, h) + aoff + m * 2048 + k * 1024); } while (0)
#define PG8_LDB(dst, b, h) do { _Pragma("unroll") for (int n = 0; n < 2; ++n) _Pragma("unroll") for (int k = 0; k < 2; ++k) dst[n][k] = *(const PG8_LAS bf16x8*)(lds + PG8_SB(b, h) + boff + n * 2048 + k * 1024); } while (0)
#define PG8_MMA(ai, bj, At, Bt) do { __builtin_amdgcn_s_setprio(1); _Pragma("unroll") for (int m = 0; m < 4; ++m) _Pragma("unroll") for (int n = 0; n < 2; ++n) _Pragma("unroll") for (int k = 0; k < 2; ++k) \
        acc[ai][bj][m][n] = __builtin_amdgcn_mfma_f32_16x16x32_bf16(Bt[n][k], At[m][k], acc[ai][bj][m][n], 0, 0, 0); __builtin_amdgcn_s_setprio(0); } while (0)
#define PG8_WAIT_V(n) asm volatile("s_waitcnt vmcnt(" #n ")" ::: "memory")
#define PG8_WAIT_L(n) asm volatile("s_waitcnt lgkmcnt(" #n ")" ::: "memory")
#define PG8_BAR __builtin_amdgcn_s_barrier()
#define PG8_SCHED __builtin_amdgcn_sched_barrier(0)
    Unit cur, nxt; int ui = 0;
    if (!S.next(0, cur)) return;
    f32x4 acc[2][2][4][2];
#pragma unroll
    for (int a = 0; a < 2; ++a)
#pragma unroll
        for (int b = 0; b < 2; ++b)
#pragma unroll
            for (int m = 0; m < 4; ++m)
#pragma unroll
                for (int n = 0; n < 2; ++n) acc[a][b][m][n] = (f32x4){0.f, 0.f, 0.f, 0.f};
    bf16x8 At[4][2], B0[2][2], B1[2][2];
    const char* cA = (const char*)g.A + (size_t)cur.pm * tstep; const char* cB = (const char*)g.Bt + (size_t)cur.pn * tstep;
    S.a_ready(cur);
    if constexpr (SP2) {
        PG8_STAGE(PG8_SB(0, 0), cB, voffB); PG8_STAGE(PG8_SB(0, 1), cB + hstep, voffB); PG8_STAGE(PG8_SA(0, 0), cA, voffA); PG8_STAGE(PG8_SA(0, 1), cA + hstep, voffA);
        if (wr == 1) PG8_BAR;
        PG8_WAIT_V(2); PG8_BAR;
        PG8_STAGE(PG8_SB(1, 0), cB + kstep, voffB); PG8_STAGE(PG8_SA(1, 0), cA + kstep, voffA); PG8_STAGE(PG8_SB(1, 1), cB + hstep + kstep, voffB);
        PG8_WAIT_V(6); PG8_BAR;
    } else {
        PG8_STAGE(PG8_SB(0, 0), cB, voffB); PG8_STAGE(PG8_SA(0, 0), cA, voffA); PG8_STAGE(PG8_SB(0, 1), cB + hstep, voffB); PG8_STAGE(PG8_SA(0, 1), cA + hstep, voffA);
        if (wr == 1) PG8_BAR;
        PG8_WAIT_V(4); PG8_BAR;
        PG8_STAGE(PG8_SB(1, 0), cB + kstep, voffB); PG8_STAGE(PG8_SA(1, 0), cA + kstep, voffA); PG8_STAGE(PG8_SB(1, 1), cB + hstep + kstep, voffB);
        PG8_WAIT_V(6); PG8_BAR;
    }
    for (;;) {
        const bool has_next = S.next(ui + 1, nxt);
        const char* nA = has_next ? (const char*)g.A + (size_t)nxt.pm * tstep : cA; const char* nB = has_next ? (const char*)g.Bt + (size_t)nxt.pn * tstep : cB;
        for (int t = 0; t < nt; t += 2) {
            const bool last = (t == nt - 2);
            const char* a1 = cA + (size_t)(t + 1) * kstep;
            const char* a2 = last ? nA : cA + (size_t)(t + 2) * kstep; const char* b2 = last ? nB : cB + (size_t)(t + 2) * kstep;
            const char* a3 = a2 + kstep; const char* b3 = b2 + kstep;
            if (last && has_next) S.a_ready(nxt);
            if constexpr (SP2) {
            PG8_LDB(B0, 0, 0); PG8_LDB(B1, 0, 1); PG8_SCHED; PG8_LDA(At, 0, 0); PG8_STAGE(PG8_SA(1, 1), a1 + hstep, voffA);
            PG8_WAIT_V(8); PG8_WAIT_L(0); PG8_BAR; PG8_MMA(0, 0, At, B0); PG8_MMA(0, 1, At, B1); PG8_BAR; PG8_SCHED;
            PG8_LDA(At, 0, 1); PG8_STAGE(PG8_SB(0, 0), b2, voffB); PG8_STAGE(PG8_SB(0, 1), b2 + hstep, voffB); PG8_STAGE(PG8_SA(0, 0), a2, voffA);
            PG8_WAIT_V(8); PG8_WAIT_L(0); PG8_BAR; PG8_MMA(1, 0, At, B0); PG8_MMA(1, 1, At, B1); PG8_BAR; PG8_SCHED;
            PG8_LDB(B0, 1, 0); PG8_LDB(B1, 1, 1); PG8_SCHED; PG8_LDA(At, 1, 0); PG8_STAGE(PG8_SA(0, 1), a2 + hstep, voffA);
            PG8_WAIT_V(8); PG8_WAIT_L(0); PG8_BAR; PG8_MMA(0, 0, At, B0); PG8_MMA(0, 1, At, B1); PG8_BAR; PG8_SCHED;
            PG8_LDA(At, 1, 1); PG8_STAGE(PG8_SB(1, 0), b3, voffB); PG8_STAGE(PG8_SB(1, 1), b3 + hstep, voffB); PG8_STAGE(PG8_SA(1, 0), a3, voffA);
            PG8_WAIT_V(8); PG8_WAIT_L(0); PG8_BAR; PG8_MMA(1, 0, At, B0); PG8_MMA(1, 1, At, B1); PG8_BAR; PG8_SCHED;
            } else {
            PG8_LDB(B0, 0, 0); PG8_SCHED; PG8_LDA(At, 0, 0); PG8_STAGE(PG8_SA(1, 1), a1 + hstep, voffA);
            PG8_WAIT_L(8); PG8_BAR; PG8_WAIT_L(0); PG8_MMA(0, 0, At, B0); PG8_BAR; PG8_SCHED;
            PG8_LDB(B1, 0, 1); PG8_STAGE(PG8_SB(0, 0), b2, voffB);
            PG8_BAR; PG8_WAIT_L(0); PG8_MMA(0, 1, At, B1); PG8_BAR;
            PG8_LDA(At, 0, 1); PG8_STAGE(PG8_SA(0, 0), a2, voffA);
            PG8_BAR; PG8_WAIT_L(0); PG8_MMA(1, 0, At, B0); PG8_BAR; PG8_SCHED;
            PG8_STAGE(PG8_SB(0, 1), b2 + hstep, voffB);
            PG8_WAIT_V(6); PG8_BAR; PG8_MMA(1, 1, At, B1); PG8_BAR;
            PG8_LDB(B0, 1, 0); PG8_SCHED; PG8_LDA(At, 1, 0); PG8_STAGE(PG8_SA(0, 1), a2 + hstep, voffA);
            PG8_WAIT_L(8); PG8_BAR; PG8_WAIT_L(0); PG8_MMA(0, 0, At, B0); PG8_BAR; PG8_SCHED;
            PG8_LDB(B1, 1, 1); PG8_STAGE(PG8_SB(1, 0), b3, voffB);
            PG8_BAR; PG8_WAIT_L(0); PG8_MMA(0, 1, At, B1); PG8_BAR;
            PG8_LDA(At, 1, 1); PG8_STAGE(PG8_SA(1, 0), a3, voffA);
            PG8_BAR; PG8_WAIT_L(0); PG8_MMA(1, 0, At, B0); PG8_BAR; PG8_SCHED;
            PG8_STAGE(PG8_SB(1, 1), b3 + hstep, voffB);
            PG8_WAIT_V(6); PG8_BAR; PG8_MMA(1, 1, At, B1); PG8_BAR;
            }
        }
        if constexpr (ALIGN_EPI) { if (wr == 0) PG8_BAR; }
        if constexpr (!Epi::AFTER_DRAIN) { E(acc, cur, wr, wc, fr, fq); S.done(cur); }
        if (!has_next) break;
#pragma unroll
        for (int a = 0; a < 2; ++a)
#pragma unroll
            for (int b = 0; b < 2; ++b)
#pragma unroll
                for (int m = 0; m < 4; ++m)
#pragma unroll
                    for (int n = 0; n < 2; ++n) acc[a][b][m][n] = (f32x4){0.f, 0.f, 0.f, 0.f};
        cur = nxt; cA = nA; cB = nB; ++ui;
        if constexpr (ALIGN_EPI) { if (wr == 1) PG8_BAR; }
    }
    PG8_WAIT_V(0);
    if constexpr (!ALIGN_EPI) { if (wr == 0) PG8_BAR; }
    PG8_BAR;
    if constexpr (Epi::AFTER_DRAIN) { E.fused(acc, cur, wr, wc, fr, fq, lds, wid, lane); S.done(cur); }
#undef PG8_SA
#undef PG8_SB
#undef PG8_STAGE
#undef PG8_LDA
#undef PG8_LDB
#undef PG8_MMA
#undef PG8_WAIT_V
#undef PG8_WAIT_L
#undef PG8_BAR
#undef PG8_SCHED
}
}
constexpr int S_ = 8192, D_ = 2048, DIN = 12288, DEPTH = 4;
constexpr size_t MiB = 1u << 20;
constexpr size_t WS_CTL = 3 * MiB, CTL_BYTES = 65536;
constexpr size_t WS_MOD = 0, WS_ROPE = 1 * MiB, WS_WIN = 4 * MiB, WS_WOUT = 196 * MiB, WS_WO = 228 * MiB, WS_H = 260 * MiB, WS_Q = 292 * MiB, WS_K = 308 * MiB, WS_V = 324 * MiB,
                 WS_VG = 340 * MiB, WS_GG = 356 * MiB, WS_ZB = 372 * MiB, WS_R = 388 * MiB, WS_SB = 420 * MiB, WS_YCAT = 452 * MiB, WS_MG = 484 * MiB, WS_X = 516 * MiB, WS_T = 580 * MiB, WS_END = 644 * MiB;
constexpr int LDS_BYTES = 147456;
#define LAS __attribute__((address_space(3)))
typedef unsigned short bf16;
typedef unsigned v4u __attribute__((ext_vector_type(4)));
typedef unsigned v2u __attribute__((ext_vector_type(2)));
typedef float f32x4 __attribute__((ext_vector_type(4)));
typedef float f32x16 __attribute__((ext_vector_type(16)));
typedef short bf16x8 __attribute__((ext_vector_type(8)));
typedef short s16x4 __attribute__((ext_vector_type(4)));
using pg8::cvt_pk_bf16; using pg8::bf_lo; using pg8::bf_hi; using pg8::fexp2; using pg8::frcp; using pg8::L2E;

struct Args { const float* in[17]; float* out; unsigned char* ws; int ph_lo, ph_hi; };

__device__ __forceinline__ float wave_sum(float v) {
    v += pg8::swz_xor<1>(v); v += pg8::swz_xor<2>(v); v += pg8::swz_xor<4>(v); v += pg8::swz_xor<8>(v); v += pg8::swz_xor<16>(v);
    return pg8::sum_x32(v);
}
__device__ __forceinline__ int map_in(int n0) {
    if (n0 < 4096) { const int seg = n0 >> 10, ch = n0 & 1023; const int tile = ((seg & 1) ? 8 : 0) + (ch >> 7); return tile * 256 + ((seg >> 1) ? 128 : 0) + (ch & 127); }
    if (n0 < 6144) { const int isk = n0 >= 5120, e = n0 - (isk ? 5120 : 4096), g = e >> 6, d = e & 63; return (16 + 4 * isk + (g >> 2)) * 256 + 128 * (d >> 5) + 32 * (g & 3) + (d & 31); }
    if (n0 < 8192) return n0;
    { const int isb = n0 >= 10240, j = n0 - (isb ? 10240 : 8192); return (32 + (j >> 7)) * 256 + 128 * isb + (j & 127); }
}
__device__ __forceinline__ void transpose_item(const float* W, int N, bf16* WT, int ldd, int koff, int k0, int n0, int drow0, LAS float* scr, int lane) {
    {
        f32x4 v[8]; const float* src = W + (size_t)(k0 + (lane >> 3)) * N + n0 + 4 * (lane & 7);
#pragma unroll
        for (int i = 0; i < 8; ++i) v[i] = __builtin_nontemporal_load((const f32x4*)(src + (size_t)(8 * i) * N));
#pragma unroll
        for (int i = 0; i < 8; ++i) { LAS float* d = scr + (8 * i + (lane >> 3)) * 33 + 4 * (lane & 7); d[0] = v[i].x; d[1] = v[i].y; d[2] = v[i].z; d[3] = v[i].w; }
    }
    asm volatile("s_waitcnt lgkmcnt(0)" ::: "memory");
    const int c = lane & 7;
#pragma unroll
    for (int j = 0; j < 4; ++j) { const int n = (lane >> 3) + 8 * j; const LAS float* s = scr + (8 * c) * 33 + n;
        v4u o; o.x = cvt_pk_bf16(s[0 * 33], s[1 * 33]); o.y = cvt_pk_bf16(s[2 * 33], s[3 * 33]); o.z = cvt_pk_bf16(s[4 * 33], s[5 * 33]); o.w = cvt_pk_bf16(s[6 * 33], s[7 * 33]);
        *(v4u*)(WT + (size_t)(drow0 + n) * ldd + koff + k0 + 8 * c) = o; }
    asm volatile("s_waitcnt lgkmcnt(0)" ::: "memory");
}
__device__ __forceinline__ void prologue(const Args& a, LAS unsigned char* lds, int tid, int lane, int wave) {
    unsigned char* ws = a.ws;
    if (blockIdx.x < 192 || gridDim.x < 192) {
        LAS float* cact = (LAS float*)lds; LAS float* red = (LAS float*)(lds + 8192);
        for (int i = tid; i < D_; i += 512) { const float v = a.in[1][i]; cact[i] = pg8::silu_f(v); }
        __syncthreads();
        for (int cgi = blockIdx.x; cgi < 192; cgi += gridDim.x) {
            const int l = cgi / 48, col0 = (cgi % 48) * 128 + 2 * lane;
            const float* w = a.in[2] + (size_t)l * D_ * 6144 + col0; float s0 = 0.f, s1 = 0.f;
#pragma unroll 8
            for (int k = wave * 256; k < wave * 256 + 256; ++k) { const float2 v = *(const float2*)(w + (size_t)k * 6144); const float cv = cact[k]; s0 += cv * v.x; s1 += cv * v.y; }
            red[wave * 128 + 2 * lane] = s0; red[wave * 128 + 2 * lane + 1] = s1;
            __syncthreads();
            if (tid < 128) { float s = a.in[3][l * 6144 + (cgi % 48) * 128 + tid];
#pragma unroll
                for (int w8 = 0; w8 < 8; ++w8) s += red[w8 * 128 + tid];
                ((float*)(ws + WS_MOD))[l * 6144 + (cgi % 48) * 128 + tid] = s; }
            __syncthreads();
        }
    }
    for (int e = blockIdx.x * 512 + tid; e < S_ * 32; e += gridDim.x * 512) {
        const int pos = e >> 5, i = e & 31; const float inv = exp2f(-(float)i * (13.287712379549449f / 32.0f)); const float ang = (float)pos * inv;
        const double rev = (double)ang * 0.15915494309189535; const float fr = (float)(rev - floor(rev));
        ((float2*)(ws + WS_ROPE))[e] = make_float2(__builtin_amdgcn_cosf(fr), __builtin_amdgcn_sinf(fr));
    }
    LAS float* scr = (LAS float*)(lds + wave * 16384);
    const int gw = blockIdx.x * 8 + wave, NGW = gridDim.x * 8;
    constexpr int I_IN = 32 * 384, I_C = 16 * 64, I_A = 16 * 64, I_O = 32 * 64, I_L = I_IN + I_C + I_A + I_O;
    for (int it = gw; it < DEPTH * I_L; it += NGW) {
        const int l = it / I_L; int r = it % I_L;
        if (r < I_IN) { const int kb = r / 384, nb = r % 384; transpose_item(a.in[5] + (size_t)l * D_ * DIN, DIN, (bf16*)(ws + WS_WIN) + (size_t)l * DIN * D_, D_, 0, 64 * kb, 32 * nb, map_in(32 * nb), scr, lane); continue; } r -= I_IN;
        if (r < I_C) { const int kb = r / 64, nb = r % 64; transpose_item(a.in[7] + (size_t)l * 1024 * D_, D_, (bf16*)(ws + WS_WOUT) + (size_t)l * D_ * D_, 1024, 0, 64 * kb, 32 * nb, 32 * nb, scr, lane); continue; } r -= I_C;
        if (r < I_A) { const int kb = r / 64, nb = r % 64; transpose_item(a.in[15] + (size_t)l * 1024 * D_, D_, (bf16*)(ws + WS_WOUT) + (size_t)l * D_ * D_ + (size_t)D_ * 1024, 1024, 0, 64 * kb, 32 * nb, 32 * nb, scr, lane); continue; } r -= I_A;
        { const int kb = r / 64, nb = r % 64; transpose_item(a.in[16] + (size_t)l * D_ * D_, D_, (bf16*)(ws + WS_WO) + (size_t)l * D_ * D_, D_, 0, 64 * kb, 32 * nb, 32 * nb, scr, lane); }
    }
}
__device__ __forceinline__ void norm_phase(const float* x, const float* g, const float* mod, bf16* H, int lane, int wave) {
    const int gw = blockIdx.x * 8 + wave, NGW = gridDim.x * 8;
    for (int row = gw; row < S_; row += 2 * NGW) {
        const int row2 = row + NGW; const bool has2 = row2 < S_;
        const f32x4* xr = (const f32x4*)(x + (size_t)row * D_) + lane; const f32x4* xr2 = (const f32x4*)(x + (size_t)(has2 ? row2 : row) * D_) + lane;
        f32x4 v[8], u[8]; float s = 0.f, s2 = 0.f;
#pragma unroll
        for (int j = 0; j < 8; ++j) { v[j] = xr[64 * j]; u[j] = xr2[64 * j]; }
#pragma unroll
        for (int j = 0; j < 8; ++j) { s += (v[j].x * v[j].x + v[j].y * v[j].y) + (v[j].z * v[j].z + v[j].w * v[j].w); s2 += (u[j].x * u[j].x + u[j].y * u[j].y) + (u[j].z * u[j].z + u[j].w * u[j].w); }
        const float rinv = __builtin_amdgcn_rsqf(wave_sum(s) * (1.0f / D_) + 1e-6f), rinv2 = __builtin_amdgcn_rsqf(wave_sum(s2) * (1.0f / D_) + 1e-6f);
        v2u* o8 = (v2u*)(H + (size_t)row * D_) + lane; v2u* o82 = (v2u*)(H + (size_t)row2 * D_) + lane;
#pragma unroll
        for (int j = 0; j < 8; ++j) { const int col = 4 * lane + 256 * j; const f32x4 gg = *(const f32x4*)(g + col), sh = *(const f32x4*)(mod + col), sc = *(const f32x4*)(mod + 2048 + col);
            const f32x4 gs = gg * (sc + 1.0f);
            const f32x4 y = v[j] * rinv * gs + sh; v2u w; w.x = cvt_pk_bf16(y.x, y.y); w.y = cvt_pk_bf16(y.z, y.w); o8[64 * j] = w;
            if (has2) { const f32x4 y2 = u[j] * rinv2 * gs + sh; v2u w2; w2.x = cvt_pk_bf16(y2.x, y2.y); w2.y = cvt_pk_bf16(y2.z, y2.w); o82[64 * j] = w2; } }
    }
}
__device__ __forceinline__ void conv_phase(const bf16* VG, const bf16* GG, const float* cw, bf16* YCAT, int tid) {
    for (int item = blockIdx.x * 512 + tid; item < 1024 * 128; item += gridDim.x * 512) {
        const int cgp = item & 127, rg = item >> 7, ch = cgp * 8, t0 = rg * 8;
        float w0[8], w1[8], w2[8], v0[8], v1[8];
#pragma unroll
        for (int j = 0; j < 8; ++j) { w0[j] = cw[ch + j]; w1[j] = cw[1024 + ch + j]; w2[j] = cw[2048 + ch + j]; v0[j] = 0.f; v1[j] = 0.f; }
        if (t0 > 0) { const v4u a = *(const v4u*)(VG + (size_t)(t0 - 2) * 1024 + ch), b = *(const v4u*)(VG + (size_t)(t0 - 1) * 1024 + ch);
            v0[0] = bf_lo(a.x); v0[1] = bf_hi(a.x); v0[2] = bf_lo(a.y); v0[3] = bf_hi(a.y); v0[4] = bf_lo(a.z); v0[5] = bf_hi(a.z); v0[6] = bf_lo(a.w); v0[7] = bf_hi(a.w);
            v1[0] = bf_lo(b.x); v1[1] = bf_hi(b.x); v1[2] = bf_lo(b.y); v1[3] = bf_hi(b.y); v1[4] = bf_lo(b.z); v1[5] = bf_hi(b.z); v1[6] = bf_lo(b.w); v1[7] = bf_hi(b.w); }
#pragma unroll
        for (int i = 0; i < 8; ++i) { const v4u a = *(const v4u*)(VG + (size_t)(t0 + i) * 1024 + ch), gq = *(const v4u*)(GG + (size_t)(t0 + i) * 1024 + ch);
            float v2[8], gv[8], y[8];
            v2[0] = bf_lo(a.x); v2[1] = bf_hi(a.x); v2[2] = bf_lo(a.y); v2[3] = bf_hi(a.y); v2[4] = bf_lo(a.z); v2[5] = bf_hi(a.z); v2[6] = bf_lo(a.w); v2[7] = bf_hi(a.w);
            gv[0] = bf_lo(gq.x); gv[1] = bf_hi(gq.x); gv[2] = bf_lo(gq.y); gv[3] = bf_hi(gq.y); gv[4] = bf_lo(gq.z); gv[5] = bf_hi(gq.z); gv[6] = bf_lo(gq.w); gv[7] = bf_hi(gq.w);
#pragma unroll
            for (int j = 0; j < 8; ++j) { y[j] = gv[j] * (w0[j] * v0[j] + w1[j] * v1[j] + w2[j] * v2[j]); v0[j] = v1[j]; v1[j] = v2[j]; }
            v4u o; o.x = cvt_pk_bf16(y[0], y[1]); o.y = cvt_pk_bf16(y[2], y[3]); o.z = cvt_pk_bf16(y[4], y[5]); o.w = cvt_pk_bf16(y[6], y[7]);
            *(v4u*)(YCAT + (size_t)(t0 + i) * 1024 + ch) = o; }
    }
}
namespace att {
constexpr int KS = 144, VS = 320, KT_BYTES = 2 * 64 * KS, VT_BYTES = 64 * VS, BUF = KT_BYTES + VT_BYTES;
constexpr float THR = 24.0f;
__device__ __forceinline__ int crow(int r, int hi) { return (r & 3) + 8 * (r >> 2) + 4 * hi; }
__device__ __forceinline__ s16x4 vtr(const LAS unsigned char* p) { return __builtin_bit_cast(s16x4, __builtin_amdgcn_ds_read_tr16_b64_v4i16((LAS s16x4*)p)); }
#define ATT_SB() __builtin_amdgcn_sched_barrier(0)
__device__ __forceinline__ bf16x8 pack_slab(const f32x16& p, int s2) { v4u u_; u_.x = cvt_pk_bf16(p[8 * s2], p[8 * s2 + 1]); u_.y = cvt_pk_bf16(p[8 * s2 + 2], p[8 * s2 + 3]); u_.z = cvt_pk_bf16(p[8 * s2 + 4], p[8 * s2 + 5]); u_.w = cvt_pk_bf16(p[8 * s2 + 6], p[8 * s2 + 7]); return __builtin_bit_cast(bf16x8, u_); }
__device__ __forceinline__ void unit(LAS unsigned char* lds, const bf16* Q, const bf16* K, const bf16* V, const bf16* ZB, bf16* YCAT, const float* subg, float lam, float oscale, int h, int qb, int tid_in, int lane_in, int w) {
    int lane = (int)__builtin_amdgcn_mbcnt_hi(~0u, __builtin_amdgcn_mbcnt_lo(~0u, 0u)); asm volatile("" : "+v"(lane)); const int tid = w * 64 + lane;
    const int c = w >> 2, wq = w & 3; int r32 = lane & 31, hi = lane >> 5;
    const int q0 = 128 * qb + 32 * wq, NT = 2 * qb + 2, ntw = (q0 >> 6) + 1;
    LAS unsigned char* qlds = lds + 2 * KT_BYTES + 2 * VT_BYTES + w * 4096 + lane * 16;
    { const bf16* qp = Q + (size_t)(q0 + r32) * 1024 + 128 * h + 64 * c + 8 * hi;
#pragma unroll
      for (int ks = 0; ks < 4; ++ks) *(LAS bf16x8*)(qlds + ks * 1024) = *(const bf16x8*)(qp + 16 * ks); }
#define ATT_Q(ks) (*(const LAS bf16x8*)(qlds + (ks) * 1024))
    const int key_s = tid >> 4, ch_s = tid & 15;
    const unsigned goff = (unsigned)(key_s * 1024 + ch_s * 8) * 2u;
    const char* kgb = (const char*)(K + 128 * h); const char* vgb = (const char*)(V + 128 * h);
    const int kdst = (ch_s >> 3) * 64 * KS + key_s * KS + (ch_s & 7) * 16, vdst = 2 * KT_BYTES + key_s * VS + ch_s * 16;
    v4u kr[2], vr[2];
#define ATT_LOADK(t) do { _Pragma("unroll") for (int i_ = 0; i_ < 2; ++i_) kr[i_] = *(const v4u*)(kgb + (size_t)(64 * (t) + 32 * i_) * 2048 + goff); } while (0)
#define ATT_LOADV(t) do { _Pragma("unroll") for (int i_ = 0; i_ < 2; ++i_) vr[i_] = *(const v4u*)(vgb + (size_t)(64 * (t) + 32 * i_) * 2048 + goff); } while (0)
#define ATT_STOREK(b) do { _Pragma("unroll") for (int i_ = 0; i_ < 2; ++i_) *(LAS v4u*)(lds + (b) * KT_BYTES + kdst + 32 * i_ * KS) = kr[i_]; } while (0)
#define ATT_STOREV(b) do { _Pragma("unroll") for (int i_ = 0; i_ < 2; ++i_) *(LAS v4u*)(lds + (b) * VT_BYTES + vdst + 32 * i_ * VS) = vr[i_]; } while (0)
    const int kfo = c * 64 * KS + r32 * KS + hi * 16;
    const int vfo = 2 * KT_BYTES + (4 * hi + ((lane & 15) >> 2)) * VS + (16 * ((lane >> 4) & 1) + 4 * (lane & 3)) * 2;
    ATT_LOADK(0); ATT_LOADV(0); ATT_STOREK(0); ATT_STOREV(0); ATT_LOADK(1); ATT_STOREK(1);
    f32x16 o[4];
#pragma unroll
    for (int b = 0; b < 4; ++b) o[b] = f32x16{};
    float mref = 0.f, l = 0.f; f32x16 negm = f32x16{}; asm volatile("" : "+v"(negm));
    f32x16 sa = f32x16{}, sb = f32x16{}, sc = f32x16{}, sd = f32x16{};
    __syncthreads();
    { const LAS unsigned char* kb = lds + kfo;
#pragma unroll
      for (int ks = 0; ks < 4; ++ks) { const bf16x8 a0 = *(const LAS bf16x8*)(kb + ks * 32), a1 = *(const LAS bf16x8*)(kb + 32 * KS + ks * 32);
          sa = __builtin_amdgcn_mfma_f32_32x32x16_bf16(a0, ATT_Q(ks), sa, 0, 0, 0); sb = __builtin_amdgcn_mfma_f32_32x32x16_bf16(a1, ATT_Q(ks), sb, 0, 0, 0); }
      float rm = fmaxf(sa[0], sb[0]);
#pragma unroll
      for (int r_ = 1; r_ < 16; ++r_) rm = fmaxf(rm, fmaxf(sa[r_], sb[r_]));
      rm = pg8::max_x32(rm);
      if (__any(rm < -THR)) { mref = fminf(rm, 0.f);
#pragma unroll
          for (int r_ = 0; r_ < 16; ++r_) { sa[r_] -= mref; sb[r_] -= mref; negm[r_] = -mref; } } }
#define ATT_EXP8(P, s2) do { _Pragma("unroll") for (int r_ = 0; r_ < 8; ++r_) { P[8 * (s2) + r_] = fexp2(P[8 * (s2) + r_]); ls += P[8 * (s2) + r_]; } } while (0)
#define ATT_VRD(dst, s_) do { _Pragma("unroll") for (int b_ = 0; b_ < 4; ++b_) { const s16x4 lo_ = vtr(vb + (s_) * 16 * VS + b_ * 64), hh_ = vtr(vb + (s_) * 16 * VS + 8 * VS + b_ * 64); \
        dst[b_] = (bf16x8){lo_[0], lo_[1], lo_[2], lo_[3], hh_[0], hh_[1], hh_[2], hh_[3]}; } } while (0)
#define ATT_PV(vf, pw_) do { _Pragma("unroll") for (int b_ = 0; b_ < 4; ++b_) o[b_] = __builtin_amdgcn_mfma_f32_32x32x16_bf16(vf[b_], pw_, o[b_], 0, 0, 0); } while (0)
#define ATT_MAX3(a_, b_, c_) ({ float r__; asm("v_max3_f32 %0, %1, %2, %3" : "=v"(r__) : "v"(a_), "v"(b_), "v"(c_)); r__; })
#define ATT_ROWMAX(dst, X0, X1) do { float a__ = ATT_MAX3(X0[0], X0[1], X1[0]), b__ = ATT_MAX3(X0[2], X0[3], X1[1]); a__ = ATT_MAX3(a__, X1[2], X1[3]); \
        _Pragma("unroll") for (int r_ = 4; r_ < 16; r_ += 4) { a__ = ATT_MAX3(a__, X0[r_], X0[r_ + 1]); b__ = ATT_MAX3(b__, X0[r_ + 2], X0[r_ + 3]); a__ = ATT_MAX3(a__, X1[r_], X1[r_ + 1]); b__ = ATT_MAX3(b__, X1[r_ + 2], X1[r_ + 3]); } \
        dst = ATT_MAX3(a__, b__, b__); } while (0)
#define ATT_STEP(C0, C1, N0, N1, t) do { \
        __syncthreads(); \
        const LAS unsigned char* kb = lds + (((t) + 1) & 1) * KT_BYTES + kfo; const LAS unsigned char* vb = lds + ((t) & 1) * VT_BYTES + vfo; \
        { float rm; ATT_ROWMAX(rm, C0, C1); \
          if (__any(rm > THR)) { rm = pg8::max_x32(rm); const float dl = fmaxf(rm, 0.f); mref += dl; const float al = fexp2(-dl); l *= al; \
              _Pragma("unroll") for (int r_ = 0; r_ < 16; ++r_) { C0[r_] -= dl; C1[r_] -= dl; negm[r_] = -mref; } \
              _Pragma("unroll") for (int b_ = 0; b_ < 4; ++b_) o[b_] *= al; } } \
        bf16x8 kf[4], vfa[4], qa, qb_; float ls = 0.f; bf16x8 pwa; \
        qa = ATT_Q(0); qb_ = ATT_Q(1); \
        _Pragma("unroll") for (int ks = 0; ks < 2; ++ks) { kf[2 * ks] = *(const LAS bf16x8*)(kb + ks * 32); kf[2 * ks + 1] = *(const LAS bf16x8*)(kb + 32 * KS + ks * 32); } \
        ATT_VRD(vfa, 0); ATT_SB(); ATT_EXP8(C0, 0); pwa = pack_slab(C0, 0); ATT_SB(); \
        N0 = __builtin_amdgcn_mfma_f32_32x32x16_bf16(kf[0], qa, negm, 0, 0, 0); N1 = __builtin_amdgcn_mfma_f32_32x32x16_bf16(kf[1], qa, negm, 0, 0, 0); \
        N0 = __builtin_amdgcn_mfma_f32_32x32x16_bf16(kf[2], qb_, N0, 0, 0, 0); N1 = __builtin_amdgcn_mfma_f32_32x32x16_bf16(kf[3], qb_, N1, 0, 0, 0); \
        qa = ATT_Q(2); qb_ = ATT_Q(3); \
        _Pragma("unroll") for (int ks = 0; ks < 2; ++ks) { kf[2 * ks] = *(const LAS bf16x8*)(kb + (ks + 2) * 32); kf[2 * ks + 1] = *(const LAS bf16x8*)(kb + 32 * KS + (ks + 2) * 32); } \
        ATT_PV(vfa, pwa); ATT_VRD(vfa, 1); ATT_EXP8(C0, 1); pwa = pack_slab(C0, 1); ATT_SB(); \
        N0 = __builtin_amdgcn_mfma_f32_32x32x16_bf16(kf[0], qa, N0, 0, 0, 0); N1 = __builtin_amdgcn_mfma_f32_32x32x16_bf16(kf[1], qa, N1, 0, 0, 0); \
        N0 = __builtin_amdgcn_mfma_f32_32x32x16_bf16(kf[2], qb_, N0, 0, 0, 0); N1 = __builtin_amdgcn_mfma_f32_32x32x16_bf16(kf[3], qb_, N1, 0, 0, 0); \
        ATT_SB(); if ((t) + 2 < NT) ATT_LOADK((t) + 2); \
        if ((t) + 1 < NT) ATT_LOADV((t) + 1); \
        ATT_PV(vfa, pwa); ATT_VRD(vfa, 2); ATT_EXP8(C1, 0); pwa = pack_slab(C1, 0); ATT_SB(); \
        ATT_PV(vfa, pwa); ATT_VRD(vfa, 3); ATT_EXP8(C1, 1); pwa = pack_slab(C1, 1); ATT_SB(); \
        ATT_PV(vfa, pwa); l += ls; \
        if ((t) + 1 >= ntw) { asm volatile("" ::: "memory"); _Pragma("unroll") for (int r_ = 0; r_ < 16; ++r_) { N0[r_] = -1e30f; N1[r_] = -1e30f; } } \
        if ((t) + 2 < NT) ATT_STOREK((t) & 1); \
        if ((t) + 1 < NT) ATT_STOREV(((t) + 1) & 1); \
    } while (0)
    for (int t = 0; t < NT; t += 2) { ATT_STEP(sa, sb, sc, sd, t); ATT_STEP(sc, sd, sa, sb, t + 1); }
#undef ATT_MAX3
#undef ATT_ROWMAX
#undef ATT_LOADK
#undef ATT_LOADV
#undef ATT_STOREK
#undef ATT_STOREV
#undef ATT_EXP8
#undef ATT_VRD
#undef ATT_PV
#undef ATT_STEP
    __syncthreads();
    l = pg8::sum_x32(l); const float inv = 1.0f / l;
    { lane = (int)__builtin_amdgcn_mbcnt_hi(~0u, __builtin_amdgcn_mbcnt_lo(~0u, 0u)); asm volatile("" : "+v"(lane)); r32 = lane & 31; hi = lane >> 5; }
    LAS float* ex = (LAS float*)lds + wq * 4096;
    if (c == 1) {
#pragma unroll
        for (int b = 0; b < 4; ++b)
#pragma unroll
            for (int r = 0; r < 16; ++r) ex[(32 * b + crow(r, hi)) * 32 + r32] = o[b][r] * inv;
    }
    __syncthreads();
    if (c == 0) {
        float ss = 0.f;
#pragma unroll
        for (int b = 0; b < 4; ++b)
#pragma unroll
            for (int r = 0; r < 16; ++r) { const float v = o[b][r] * inv - lam * ex[(32 * b + crow(r, hi)) * 32 + r32]; o[b][r] = v; ss += v * v; }
        ss = pg8::sum_x32(ss);
        const float rn = __builtin_amdgcn_rsqf(ss * (1.0f / 128.0f) + 1e-6f) * oscale;
        const int row = q0 + r32;
#pragma unroll
        for (int b = 0; b < 4; ++b)
#pragma unroll
            for (int g = 0; g < 4; ++g) { const int dv = 32 * b + 8 * g + 4 * hi;
                const v2u z = *(const v2u*)(ZB + (size_t)row * 1024 + 128 * h + dv); const f32x4 sg = *(const f32x4*)(subg + dv);
                v2u wv; wv.x = cvt_pk_bf16(o[b][4 * g] * rn * sg.x * bf_lo(z.x), o[b][4 * g + 1] * rn * sg.y * bf_hi(z.x)); wv.y = cvt_pk_bf16(o[b][4 * g + 2] * rn * sg.z * bf_lo(z.y), o[b][4 * g + 3] * rn * sg.w * bf_hi(z.y));
                *(v2u*)(YCAT + (size_t)S_ * 1024 + (size_t)row * 1024 + 128 * h + dv) = wv; }
    }
    __syncthreads();
}
}

#define XB_TMO      128
#define XB_XCNT(j)  (256  + 64 * (j))
#define XB_XSUB(j)  (1280 + 64 * (j))
#define XB_XGEN(j)  (2304 + 64 * (j))
#define XB_TOP      3328
#define XB_TOPGEN   3392
#define XCD_BAR_WORDS 3456
#define XB_SPIN_CAP (1u << 18)

__device__ __forceinline__ unsigned xb_ld(unsigned* p)              { return __hip_atomic_load(p, __ATOMIC_RELAXED, __HIP_MEMORY_SCOPE_AGENT); }
__device__ __forceinline__ unsigned xb_add(unsigned* p, unsigned v) { return __hip_atomic_fetch_add(p, v, __ATOMIC_RELAXED, __HIP_MEMORY_SCOPE_AGENT); }
__device__ __forceinline__ unsigned xb_xcc_id() { return (unsigned)__builtin_amdgcn_s_getreg((3 << 11) | 20) & 0xFu; }
#define XB_SPIN(cond, bar) do { unsigned _sp = 0; while (cond) { __builtin_amdgcn_s_sleep(1); \
    if ((++_sp & 255u) == 0u) { if (xb_ld(&(bar)[XB_TMO])) break; if (_sp > XB_SPIN_CAP) { atomicAdd(&(bar)[XB_TMO], 1u); break; } } } } while (0)

struct XcdBarrier {
    unsigned* bar; unsigned x;
    volatile LAS unsigned* st;
};

__device__ __forceinline__ XcdBarrier xcd_barrier_post(unsigned* bar, volatile LAS unsigned* st) {
    XcdBarrier b; b.bar = bar; b.x = xb_xcc_id(); b.st = st;
    if (threadIdx.x == 0) (void)xb_add(&bar[XB_XCNT(b.x)], 1u);
    return b;
}
__device__ __forceinline__ void xcd_barrier_complete(unsigned* bar, unsigned x, unsigned& nloc, unsigned& nx) {
    const unsigned G = gridDim.x * gridDim.y * gridDim.z;
    unsigned sum, cnt, mine, sp = 0u;
    for (;;) {
        sum = 0u; cnt = 0u; mine = 0u;
#pragma unroll
        for (unsigned j = 0; j < 16; ++j) { const unsigned c = xb_ld(&bar[XB_XCNT(j)]); sum += c; cnt += (c > 0u) ? 1u : 0u; mine = (j == x) ? c : mine; }
        if (sum == G) break;
        __builtin_amdgcn_s_sleep(1);
        if ((++sp & 255u) == 0u) { if (xb_ld(&bar[XB_TMO])) break; if (sp > XB_SPIN_CAP) { atomicAdd(&bar[XB_TMO], 1u); break; } }
    }
    nloc = mine > 0u ? mine : 1u; nx = cnt > 0u ? cnt : 1u;
}

__device__ __forceinline__ void xcd_barrier(const XcdBarrier& b) {
    asm volatile("s_waitcnt vmcnt(0)" ::: "memory");
    __syncthreads();
    if (threadIdx.x == 0) {
        unsigned* bar = b.bar;
        __builtin_amdgcn_s_waitcnt(0);
        unsigned nloc = b.st[0], nx = b.st[1];
        if (nloc == 0u) { xcd_barrier_complete(bar, b.x, nloc, nx); b.st[0] = nloc; b.st[1] = nx; }
        const unsigned old = xb_add(&bar[XB_XSUB(b.x)], 1u);
        const unsigned gen = old / nloc;
        if (old + 1u == (gen + 1u) * nloc) {
            __builtin_amdgcn_fence(__ATOMIC_RELEASE, "agent");
            asm volatile("s_waitcnt vmcnt(0)" ::: "memory");
            const unsigned og = xb_add(&bar[XB_TOP], 1u);
            const unsigned tg = og / nx;
            if (og + 1u == (tg + 1u) * nx) xb_add(&bar[XB_TOPGEN], 1u);
            else XB_SPIN(xb_ld(&bar[XB_TOPGEN]) == tg, bar);
            __builtin_amdgcn_fence(__ATOMIC_ACQUIRE, "agent");
            xb_add(&bar[XB_XGEN(b.x)], 1u);
            asm volatile("s_waitcnt vmcnt(0)" ::: "memory");
        } else {
            XB_SPIN(xb_ld(&bar[XB_XGEN(b.x)]) == gen, bar);
            __builtin_amdgcn_fence(__ATOMIC_ACQUIRE, "agent");
            asm volatile("s_waitcnt vmcnt(0)" ::: "memory");
        }
    }
    __syncthreads();
}

__global__ void __launch_bounds__(512, 2) mega_fwd(Args args) {
    extern __shared__ __attribute__((aligned(16))) unsigned char lds_raw[];
    LAS unsigned char* lds = (LAS unsigned char*)lds_raw;
    int tid = threadIdx.x, lane = tid & 63, wave = __builtin_amdgcn_readfirstlane(tid >> 6);
#define RELAUNDER() do { lane = (int)__builtin_amdgcn_mbcnt_hi(~0u, __builtin_amdgcn_mbcnt_lo(~0u, 0u)); asm volatile("" : "+v"(lane)); tid = wave * 64 + lane; } while (0)
    unsigned char* ws = args.ws;
    const int lo = args.ph_lo, hi = args.ph_hi;
    volatile LAS unsigned* bst = (volatile LAS unsigned*)(lds + 131072 + 32);
    if (tid < 2) bst[tid] = 0u;
    __syncthreads();
    XcdBarrier bar = xcd_barrier_post((unsigned*)(ws + WS_CTL), bst);
#define IN(k) (lo <= (k) && (k) < hi)
#define SEAM(k) do { if (IN(k) && IN((k) + 1)) { if ((k) == 0) cg::this_grid().sync(); else xcd_barrier(bar); } } while (0)
    if (IN(0)) {
#ifndef NO_PRO
 for (int rep_ = 0; rep_ < REP_PRO; ++rep_) { prologue(args, lds, tid, lane, wave); __syncthreads(); }
#endif
 }
    SEAM(0);
    bf16* Hb = (bf16*)(ws + WS_H); bf16* Qb = (bf16*)(ws + WS_Q); bf16* Kb = (bf16*)(ws + WS_K); bf16* Vb = (bf16*)(ws + WS_V); bf16* VG = (bf16*)(ws + WS_VG); bf16* GG = (bf16*)(ws + WS_GG);
    bf16* ZB = (bf16*)(ws + WS_ZB); bf16* Rb = (bf16*)(ws + WS_R); bf16* SBb = (bf16*)(ws + WS_SB); bf16* YC = (bf16*)(ws + WS_YCAT); bf16* MG = (bf16*)(ws + WS_MG); float* XW = (float*)(ws + WS_X);
    for (int l = 0; l < DEPTH; ++l) {
        const int pb = 1 + 5 * l;
        const float* mod = (const float*)(ws + WS_MOD) + l * 6144;
        const float* xin = (l == 0) ? args.in[0] : XW; float* xout = (l == DEPTH - 1) ? args.out : XW;
#ifndef NO_NORM
        RELAUNDER();
        if (IN(pb)) for (int rep_ = 0; rep_ < REP_NORM; ++rep_) norm_phase(xin, args.in[4] + l * D_, mod, Hb, lane, wave);
#endif
        SEAM(pb);
        if (IN(pb + 1)) {
            pg8::Gemm g{Hb, (const bf16*)(ws + WS_WIN) + (size_t)l * DIN * D_, S_, DIN, D_}; pg8::StaticOrder S; S.init(S_, DIN, gridDim.x, (int)blockIdx.x);
            pg8::InProjEpi E{Qb, Kb, Vb, VG, GG, ZB, Rb, SBb, args.in[8] + l * 64, args.in[9] + l * 64, (const float*)(ws + WS_ROPE), 0.125f * L2E};
#ifndef NO_INPROJ
            for (int rep_ = 0; rep_ < REP_INPROJ; ++rep_) pg8::gemm_phase<pg8::InProjEpi, pg8::StaticOrder, true, true>(lds, g, S, E, wave);
#endif
        }
        SEAM(pb + 1);
        if (IN(pb + 2)) { RELAUNDER();
#ifndef NO_CONV
            conv_phase(VG, GG, args.in[6] + l * 3 * 1024, YC, tid);
#endif
            const float s1 = wave_sum(args.in[10][l * 64 + lane] * args.in[11][l * 64 + lane]), s2 = wave_sum(args.in[12][l * 64 + lane] * args.in[13][l * 64 + lane]);
            const float linit = 0.8f - 0.6f * expf(-0.3f * (float)l); const float lam = expf(s1) - expf(s2) + linit;
#ifndef NO_ATT
            for (int rep_ = 0; rep_ < REP_ATT; ++rep_)
            for (int pr = blockIdx.x; pr < 256; pr += gridDim.x) { const int h = pr & 7, pi = pr >> 3;
                att::unit(lds, Qb, Kb, Vb, ZB, YC, args.in[14] + l * 128, lam, 1.0f - linit, h, 63 - pi, tid, lane, wave);
                att::unit(lds, Qb, Kb, Vb, ZB, YC, args.in[14] + l * 128, lam, 1.0f - linit, h, pi, tid, lane, wave); }
#endif
        }
        SEAM(pb + 2);
        if (IN(pb + 3)) {
            pg8::StaticOrder S; S.init(S_, D_, gridDim.x, (int)blockIdx.x); bf16* Tb = (bf16*)(ws + WS_T);
#ifndef NO_MERGE
            for (int rep_ = 0; rep_ < REP_MERGE; ++rep_) {
            { pg8::Gemm g{YC, (const bf16*)(ws + WS_WOUT) + (size_t)l * D_ * D_, S_, D_, 1024}; pg8::Merge1Epi E{Rb, Tb};
              pg8::gemm_phase<pg8::Merge1Epi, pg8::StaticOrder, true, true>(lds, g, S, E, wave); }
            { pg8::Gemm g{YC + (size_t)S_ * 1024, (const bf16*)(ws + WS_WOUT) + (size_t)l * D_ * D_ + (size_t)D_ * 1024, S_, D_, 1024}; pg8::Merge2Epi E{SBb, Tb, MG};
              pg8::gemm_phase<pg8::Merge2Epi, pg8::StaticOrder, true, true>(lds, g, S, E, wave); }
            }
#endif
        }
        SEAM(pb + 3);
        if (IN(pb + 4)) {
            pg8::Gemm g{MG, (const bf16*)(ws + WS_WO) + (size_t)l * D_ * D_, S_, D_, D_}; pg8::StaticOrder S; S.init(S_, D_, gridDim.x, (int)blockIdx.x);
            pg8::ResEpi E{xin, xout, mod + 4096};
#ifndef NO_RES
            pg8::gemm_phase<pg8::ResEpi, pg8::StaticOrder, true, true>(lds, g, S, E, wave);
#endif
        }
        SEAM(pb + 4);
    }
#undef IN
#undef SEAM
}
constexpr int N_PHASES = 1 + 5 * DEPTH;

extern "C" void kernel_launch(void* const* d_in, const int* in_sizes, int n_in, void* d_out, int out_size, void* d_ws, size_t ws_size, hipStream_t stream) {
    static int grid = 0;
    if (grid == 0) {
        if (n_in != 17 || out_size != S_ * D_ || ws_size < WS_END) { fprintf(stderr, "kernel_launch: unexpected shapes (n_in %d out %d ws %zu)\n", n_in, out_size, ws_size); grid = -1; return; }
        int dev = 0, cus = 0, per_cu = 0;
        hipGetDevice(&dev); hipDeviceGetAttribute(&cus, hipDeviceAttributeMultiprocessorCount, dev);
        if (hipFuncSetAttribute((const void*)mega_fwd, hipFuncAttributeMaxDynamicSharedMemorySize, LDS_BYTES) != hipSuccess) { fprintf(stderr, "kernel_launch: hipFuncSetAttribute failed\n"); grid = -1; return; }
        if (hipOccupancyMaxActiveBlocksPerMultiprocessor(&per_cu, (const void*)mega_fwd, 512, LDS_BYTES) != hipSuccess || per_cu < 1) { fprintf(stderr, "kernel_launch: occupancy query says %d\n", per_cu); per_cu = 1; }
        (void)hipGetLastError();
        grid = cus * 1;
        if (grid > 256) grid = 256;
    }
    if (grid < 0) return;
    if (hipMemsetAsync((char*)d_ws + WS_CTL, 0, CTL_BYTES, stream) != hipSuccess) { fprintf(stderr, "kernel_launch: memset failed\n"); return; }
    Args a{};
    for (int i = 0; i < 17; ++i) a.in[i] = (const float*)d_in[i];
    a.out = (float*)d_out; a.ws = (unsigned char*)d_ws;
#if MK_MULTI
    for (int p = 0; p < N_PHASES; ++p) { a.ph_lo = p; a.ph_hi = p + 1; hipLaunchKernelGGL(mega_fwd, dim3(grid), dim3(512), LDS_BYTES, stream, a); }
#else
    a.ph_lo = 0; a.ph_hi = N_PHASES;
    void* kargs[] = {&a};
    hipError_t e = hipLaunchCooperativeKernel((const void*)mega_fwd, dim3(grid), dim3(512), kargs, LDS_BYTES, stream);
    if (e != hipSuccess) fprintf(stderr, "cooperative launch failed: %s (grid %d)\n", hipGetErrorString(e), grid);
#endif
}
```

```cpp
#include <hip/hip_runtime.h>
#include <hip/hip_cooperative_groups.h>
#include <cstdio>
#include <cstdint>
namespace cg = cooperative_groups;
#ifndef REP_PRO
#define REP_PRO 1
#endif
#ifndef REP_NORM
#define REP_NORM 1
#endif
#ifndef REP_INPROJ
#define REP_INPROJ 1
#endif
#ifndef REP_ATT
#define REP_ATT 1
#endif
#ifndef REP_MERGE
#define REP_MERGE 1
#endif
#ifndef MK_MULTI
#define MK_MULTI 0
#endif
namespace pg8 {
#define PG8_LAS __attribute__((address_space(3)))
typedef unsigned short bf16_t;
typedef short bf16x8 __attribute__((ext_vector_type(8)));
typedef float f32x4 __attribute__((ext_vector_type(4)));
typedef unsigned u32x4 __attribute__((ext_vector_type(4)));
constexpr int BM = 256, BK = 64, HALF = 128, HTB = HALF * BK * 2  , STAGE_BYTES = 8 * HTB, NXCD = 8, WGM = 8;

__host__ __device__ __forceinline__ int lds_byte(int r, int c) { const int st = (r >> 4) * 2 + (c >> 5), rr = r & 15, cc = c & 31, ob = rr * 64 + cc * 2; return st * 1024 + (ob ^ (((ob >> 9) & 1) << 5)); }
__host__ __device__ __forceinline__ void stage_rc(int b, int& R, int& C) { const int st = b / 1024, sb = b % 1024, swz = sb ^ (((sb >> 9) & 1) << 5); R = (st >> 1) * 16 + swz / 64; C = (st & 1) * 32 + (swz % 64) / 2; }
__host__ __device__ __forceinline__ int perm32(int rho) { const int n = rho >> 4, i = rho & 15; return 8 * (i >> 2) + 4 * n + (i & 3); }

struct Unit { int pm, pn; };
struct Gemm { const bf16_t* A; const bf16_t* Bt; int M, N, K; };

struct StaticOrder {
    int nM, nN, nwg, G, c;
    __host__ __device__ void init(int M, int N, int G_, int c_) { nM = M / BM; nN = N / BM; nwg = nM * nN; G = G_; c = c_; }
    __host__ __device__ bool next(int i, Unit& u) const {
        const long L = (long)i * G + c; if (L >= nwg) return false;
        int wgid = (int)L; { const int q = nwg / NXCD, r = nwg % NXCD, xcd = wgid % NXCD, off = wgid / NXCD; wgid = (xcd < r ? xcd * (q + 1) : r * (q + 1) + (xcd - r) * q) + off; }
        const int nig = WGM * nN, gid = wgid / nig, fm = gid * WGM, gsz = (nM - fm) < WGM ? (nM - fm) : WGM;
        u.pm = fm + ((wgid % nig) % gsz); u.pn = (wgid % nig) / gsz; return true;
    }
    __device__ __forceinline__ void a_ready(const Unit&) const {}
    __device__ __forceinline__ void done(const Unit&) const {}
};

__device__ __forceinline__ unsigned cvt_pk_bf16(float lo, float hi) { unsigned r; asm volatile("v_cvt_pk_bf16_f32 %0, %1, %2" : "=v"(r) : "v"(lo), "v"(hi)); return r; }
template <int MASK> __device__ __forceinline__ float swz_xor(float v) { static_assert(MASK > 0 && MASK < 32, "ds_swizzle bit mode"); return __int_as_float(__builtin_amdgcn_ds_swizzle(__float_as_int(v), (MASK << 10) | 0x1f)); }
__device__ __forceinline__ float sum_x32(float v) { auto r = __builtin_amdgcn_permlane32_swap(__float_as_uint(v), __float_as_uint(v), false, false); return __uint_as_float(r[0]) + __uint_as_float(r[1]); }
__device__ __forceinline__ float max_x32(float v) { auto r = __builtin_amdgcn_permlane32_swap(__float_as_uint(v), __float_as_uint(v), false, false); return fmaxf(__uint_as_float(r[0]), __uint_as_float(r[1])); }
__device__ __forceinline__ float bf_lo(unsigned w) { return __uint_as_float(w << 16); }
__device__ __forceinline__ float bf_hi(unsigned w) { return __uint_as_float(w & 0xffff0000u); }
__device__ __forceinline__ float fexp2(float x) { return __builtin_amdgcn_exp2f(x); }
__device__ __forceinline__ float frcp(float x) { return __builtin_amdgcn_rcpf(x); }
constexpr float L2E = 1.4426950408889634f;
__device__ __forceinline__ float silu_f(float x) { return x * frcp(1.0f + fexp2(-x * L2E)); }
__device__ __forceinline__ u32x4 pack8(const f32x4 a, const f32x4 b) { u32x4 w; w.x = cvt_pk_bf16(a[0], a[1]); w.y = cvt_pk_bf16(a[2], a[3]); w.z = cvt_pk_bf16(b[0], b[1]); w.w = cvt_pk_bf16(b[2], b[3]); return w; }

struct InProjEpi {
    static constexpr bool PERM = true, AFTER_DRAIN = false;
    bf16_t *Q, *Kb, *V, *VG, *GG, *ZB, *R, *SB; const float* qg; const float* kg; const float* rope; float qscale;
    __device__ __forceinline__ void operator()(const f32x4 (&acc)[2][2][4][2], const Unit& u, int wr, int wc, int fr, int fq) const {
        const int pn = u.pn; const int row0 = u.pm * BM + wr * 64 + fr;
        if (pn < 16) {
            const bool bz = pn >= 8; const int jt = pn & 7; bf16_t* out = bz ? GG : VG; const int col = jt * 128 + wc * 32 + 8 * fq;
#pragma unroll
            for (int ai = 0; ai < 2; ++ai)
#pragma unroll
                for (int m = 0; m < 4; ++m) { const int row = row0 + ai * HALF + m * 16;
                    f32x4 a0 = acc[ai][0][m][0], a1 = acc[ai][0][m][1], b0 = acc[ai][1][m][0], b1 = acc[ai][1][m][1];
                    if (bz) {
#pragma unroll
                        for (int j = 0; j < 4; ++j) { b0[j] = silu_f(b0[j]); b1[j] = silu_f(b1[j]); } }
                    *(u32x4*)(out + (size_t)row * 1024 + col) = pack8(a0 * b0, a1 * b1); }
        } else if (pn < 24) {
            const bool isk = pn >= 20; const int jt = (pn - 16) & 3; const float* gw = isk ? kg : qg; bf16_t* out = isk ? Kb : Q;
            const int d0 = 8 * fq; const int colbase = 64 * (4 * jt + wc) + d0; const float sc = isk ? 1.0f : qscale;
            const f32x4 gl0 = *(const f32x4*)(gw + d0), gl1 = *(const f32x4*)(gw + d0 + 4), gh0 = *(const f32x4*)(gw + 32 + d0), gh1 = *(const f32x4*)(gw + 32 + d0 + 4);
#pragma unroll
            for (int ai = 0; ai < 2; ++ai)
#pragma unroll
                for (int m = 0; m < 4; ++m) { const int row = row0 + ai * HALF + m * 16;
                    const f32x4 xl0 = acc[ai][0][m][0], xl1 = acc[ai][0][m][1], xh0 = acc[ai][1][m][0], xh1 = acc[ai][1][m][1];
                    float ss = 0.f;
#pragma unroll
                    for (int j = 0; j < 4; ++j) ss += xl0[j] * xl0[j] + xl1[j] * xl1[j] + xh0[j] * xh0[j] + xh1[j] * xh1[j];
                    ss += swz_xor<16>(ss); ss = sum_x32(ss);
                    const float rn = __builtin_amdgcn_rsqf(ss * (1.0f / 64.0f) + 1e-6f);
                    const f32x4* rp = (const f32x4*)(rope + ((size_t)row * 32 + d0) * 2);
                    const f32x4 c0 = rp[0], c1 = rp[1], c2 = rp[2], c3 = rp[3];
                    const f32x4 al0 = xl0 * rn * gl0, al1 = xl1 * rn * gl1, ah0 = xh0 * rn * gh0, ah1 = xh1 * rn * gh1;
                    f32x4 ol0, ol1, oh0, oh1;
                    ol0[0] = al0[0] * c0[0] - ah0[0] * c0[1]; oh0[0] = ah0[0] * c0[0] + al0[0] * c0[1];
                    ol0[1] = al0[1] * c0[2] - ah0[1] * c0[3]; oh0[1] = ah0[1] * c0[2] + al0[1] * c0[3];
                    ol0[2] = al0[2] * c1[0] - ah0[2] * c1[1]; oh0[2] = ah0[2] * c1[0] + al0[2] * c1[1];
                    ol0[3] = al0[3] * c1[2] - ah0[3] * c1[3]; oh0[3] = ah0[3] * c1[2] + al0[3] * c1[3];
                    ol1[0] = al1[0] * c2[0] - ah1[0] * c2[1]; oh1[0] = ah1[0] * c2[0] + al1[0] * c2[1];
                    ol1[1] = al1[1] * c2[2] - ah1[1] * c2[3]; oh1[1] = ah1[1] * c2[2] + al1[1] * c2[3];
                    ol1[2] = al1[2] * c3[0] - ah1[2] * c3[1]; oh1[2] = ah1[2] * c3[0] + al1[2] * c3[1];
                    ol1[3] = al1[3] * c3[2] - ah1[3] * c3[3]; oh1[3] = ah1[3] * c3[2] + al1[3] * c3[3];
                    *(u32x4*)(out + (size_t)row * 1024 + colbase) = pack8(ol0 * sc, ol1 * sc);
                    *(u32x4*)(out + (size_t)row * 1024 + colbase + 32) = pack8(oh0 * sc, oh1 * sc); }
        } else if (pn < 32) {
            const bool zb = pn >= 28; const int jt = (pn - 24) & 3; bf16_t* out = zb ? ZB : V; const int col = jt * 256 + wc * 32 + 8 * fq;
#pragma unroll
            for (int ai = 0; ai < 2; ++ai)
#pragma unroll
                for (int m = 0; m < 4; ++m) { const int row = row0 + ai * HALF + m * 16;
#pragma unroll
                    for (int bj = 0; bj < 2; ++bj) { f32x4 a0 = acc[ai][bj][m][0], a1 = acc[ai][bj][m][1];
                        if (zb) {
#pragma unroll
                            for (int j = 0; j < 4; ++j) { a0[j] = silu_f(a0[j]); a1[j] = silu_f(a1[j]); } }
                        *(u32x4*)(out + (size_t)row * 1024 + col + bj * HALF) = pack8(a0, a1); } }
        } else {
            const int jt = pn - 32; const int col = jt * 128 + wc * 32 + 8 * fq;
#pragma unroll
            for (int ai = 0; ai < 2; ++ai)
#pragma unroll
                for (int m = 0; m < 4; ++m) { const int row = row0 + ai * HALF + m * 16;
                    f32x4 r0, r1, s0, s1;
#pragma unroll
                    for (int n = 0; n < 2; ++n)
#pragma unroll
                        for (int j = 0; j < 4; ++j) { const float a = acc[ai][0][m][n][j], b = acc[ai][1][m][n][j];
                            const float ea = fexp2(-a * L2E), eb = fexp2(-b * L2E); const float sb = frcp(1.0f + eb), r = frcp(1.0f + ea);
                            if (n == 0) { r0[j] = r; s0[j] = sb; } else { r1[j] = r; s1[j] = sb; } }
                    *(u32x4*)(R + (size_t)row * 2048 + col) = pack8(r0, r1);
                    *(u32x4*)(SB + (size_t)row * 2048 + col) = pack8(s0, s1); }
        }
    }
};
struct Merge1Epi {
    static constexpr bool PERM = true, AFTER_DRAIN = false;
    const bf16_t* SA; bf16_t* T;
    __device__ __forceinline__ void operator()(const f32x4 (&acc)[2][2][4][2], const Unit& u, int wr, int wc, int fr, int fq) const {
        const int row0 = u.pm * BM + wr * 64 + fr, col0 = u.pn * BM + wc * 32 + 8 * fq;
#pragma unroll
        for (int ai = 0; ai < 2; ++ai)
#pragma unroll
            for (int m = 0; m < 4; ++m) {
#pragma unroll
                for (int bj = 0; bj < 2; ++bj) { const size_t off = (size_t)(row0 + ai * HALF + m * 16) * 2048 + col0 + bj * HALF; const u32x4 w = *(const u32x4*)(SA + off);
                    *(u32x4*)(T + off) = pack8(acc[ai][bj][m][0] * (f32x4){bf_lo(w.x), bf_hi(w.x), bf_lo(w.y), bf_hi(w.y)}, acc[ai][bj][m][1] * (f32x4){bf_lo(w.z), bf_hi(w.z), bf_lo(w.w), bf_hi(w.w)}); }
                if (m & 1) asm volatile("" ::: "memory"); }
    }
};
struct Merge2Epi {
    static constexpr bool PERM = true, AFTER_DRAIN = false;
    const bf16_t* SB; const bf16_t* T; bf16_t* O;
    __device__ __forceinline__ void operator()(const f32x4 (&acc)[2][2][4][2], const Unit& u, int wr, int wc, int fr, int fq) const {
        const int row0 = u.pm * BM + wr * 64 + fr, col0 = u.pn * BM + wc * 32 + 8 * fq;
#pragma unroll
        for (int ai = 0; ai < 2; ++ai)
#pragma unroll
            for (int m = 0; m < 4; ++m) {
#pragma unroll
                for (int bj = 0; bj < 2; ++bj) { const size_t off = (size_t)(row0 + ai * HALF + m * 16) * 2048 + col0 + bj * HALF; const u32x4 w = *(const u32x4*)(SB + off);
                    const u32x4 tw = *(const u32x4*)(T + off); const f32x4 t0 = (f32x4){bf_lo(tw.x), bf_hi(tw.x), bf_lo(tw.y), bf_hi(tw.y)}, t1 = (f32x4){bf_lo(tw.z), bf_hi(tw.z), bf_lo(tw.w), bf_hi(tw.w)};
                    const f32x4 a0 = t0 + acc[ai][bj][m][0] * (f32x4){bf_lo(w.x), bf_hi(w.x), bf_lo(w.y), bf_hi(w.y)}, a1 = t1 + acc[ai][bj][m][1] * (f32x4){bf_lo(w.z), bf_hi(w.z), bf_lo(w.w), bf_hi(w.w)};
                    *(u32x4*)(O + off) = pack8(a0, a1); }
                if (m & 1) asm volatile("" ::: "memory"); }
    }
};
struct ResEpi {
    static constexpr bool PERM = false, AFTER_DRAIN = false;
    const float* xin; float* xout; const float* gate;
    __device__ __forceinline__ void operator()(const f32x4 (&acc)[2][2][4][2], const Unit& u, int wr, int wc, int fr, int fq) const {
        const int row0 = u.pm * BM + wr * 64 + fr, col0 = u.pn * BM + wc * 32 + 4 * fq;
        f32x4 gv[2][2];
#pragma unroll
        for (int bj = 0; bj < 2; ++bj)
#pragma unroll
            for (int n = 0; n < 2; ++n) gv[bj][n] = *(const f32x4*)(gate + col0 + bj * HALF + n * 16);
#pragma unroll
        for (int ai = 0; ai < 2; ++ai)
#pragma unroll
            for (int m = 0; m < 4; ++m) { const size_t off = (size_t)(row0 + ai * HALF + m * 16) * 2048 + col0;
#pragma unroll
                for (int bj = 0; bj < 2; ++bj)
#pragma unroll
                    for (int n = 0; n < 2; ++n) { const f32x4 xi = *(const f32x4*)(xin + off + bj * HALF + n * 16);
                        *(f32x4*)(xout + off + bj * HALF + n * 16) = xi + gv[bj][n] * acc[ai][bj][m][n]; } }
    }
};
template <class Epi, class Sched, bool ALIGN_EPI = false, bool SP2 = false>
__device__ __forceinline__ void gemm_phase(PG8_LAS unsigned char* lds, const Gemm g, const Sched& S, const Epi& E, int wave_sgpr) {
    int tid_ = wave_sgpr * 64 + (int)__builtin_amdgcn_mbcnt_hi(~0u, __builtin_amdgcn_mbcnt_lo(~0u, 0u)); asm volatile("" : "+v"(tid_));
    const int tid = tid_, wid = __builtin_amdgcn_readfirstlane(tid >> 6), lane = tid & 63, wr = wid >> 2, wc = wid & 3, fr = lane & 15, fq = lane >> 4;
    const int K = g.K, nt = K / BK;
    unsigned voffA[2], voffB[2];
#pragma unroll
    for (int i = 0; i < 2; ++i) { int R, C; stage_rc(tid * 16 + i * 8192, R, C); const int Rb = Epi::PERM ? ((R & ~31) + perm32(R & 31)) : R;
        voffA[i] = (unsigned)(R * K + C) * 2u; voffB[i] = (unsigned)(Rb * K + C) * 2u; }
    const size_t kstep = (size_t)(BK * 2);
    const size_t hstep = (size_t)HALF * K * 2;
    const size_t tstep = 2 * hstep;
    const unsigned ldsw = (unsigned)wid * 1024u;
    const int aoff = lds_byte(wr * 64 + fr, fq * 8), boff = lds_byte(wc * 32 + fr, fq * 8);
#define PG8_SA(b, h) (((b) * 2 + (h)) * HTB)
#define PG8_SB(b, h) ((4 + (b) * 2 + (h)) * HTB)
#define PG8_STAGE(bufoff, gbase, voff) do { _Pragma("unroll") for (int _i = 0; _i < 2; ++_i) \
        __builtin_amdgcn_global_load_lds((const unsigned*)((const char*)(gbase) + (voff)[_i]), (PG8_LAS unsigned*)(lds + (bufoff) + ldsw + _i * 8192), 16, 0, 0); } while (0)
#define PG8_LDA(dst, b, h) do { _Pragma("unroll") for (int m = 0; m < 4; ++m) _Pragma("unroll") for (int k = 0; k < 2; ++k) dst[m][k] = *(const PG8_LAS bf16x8*)(lds + PG8_SA(b, h) + aoff + m * 2048 + k * 1024); } while (0)
#define PG8_LDB(dst, b, h) do { _Pragma("unroll") for (int n = 0; n < 2; ++n) _Pragma("unroll") for (int k = 0; k < 2; ++k) dst[n][k] = *(const PG8_LAS bf16x8*)(lds + PG8_SB(b, h) + boff + n * 2048 + k * 1024); } while (0)
#define PG8_MMA(ai, bj, At, Bt) do { __builtin_amdgcn_s_setprio(1); _Pragma("unroll") for (int m = 0; m < 4; ++m) _Pragma("unroll") for (int n = 0; n < 2; ++n) _Pragma("unroll") for (int k = 0; k < 2; ++k) \
        acc[ai][bj][m][n] = __builtin_amdgcn_mfma_f32_16x16x32_bf16(Bt[n][k], At[m][k], acc[ai][bj][m][n], 0, 0, 0); __builtin_amdgcn_s_setprio(0); } while (0)
#define PG8_WAIT_V(n) asm volatile("s_waitcnt vmcnt(" #n ")" ::: "memory")
#define PG8_WAIT_L(n) asm volatile("s_waitcnt lgkmcnt(" #n ")" ::: "memory")
#define PG8_BAR __builtin_amdgcn_s_barrier()
#define PG8_SCHED __builtin_amdgcn_sched_barrier(0)
    Unit cur, nxt; int ui = 0;
    if (!S.next(0, cur)) return;
    f32x4 acc[2][2][4][2];
#pragma unroll
    for (int a = 0; a < 2; ++a)
#pragma unroll
        for (int b = 0; b < 2; ++b)
#pragma unroll
            for (int m = 0; m < 4; ++m)
#pragma unroll
                for (int n = 0; n < 2; ++n) acc[a][b][m][n] = (f32x4){0.f, 0.f, 0.f, 0.f};
    bf16x8 At[4][2], B0[2][2], B1[2][2];
    const char* cA = (const char*)g.A + (size_t)cur.pm * tstep; const char* cB = (const char*)g.Bt + (size_t)cur.pn * tstep;
    S.a_ready(cur);
    if constexpr (SP2) {
        PG8_STAGE(PG8_SB(0, 0), cB, voffB); PG8_STAGE(PG8_SB(0, 1), cB + hstep, voffB); PG8_STAGE(PG8_SA(0, 0), cA, voffA); PG8_STAGE(PG8_SA(0, 1), cA + hstep, voffA);
        if (wr == 1) PG8_BAR;
        PG8_WAIT_V(2); PG8_BAR;
        PG8_STAGE(PG8_SB(1, 0), cB + kstep, voffB); PG8_STAGE(PG8_SA(1, 0), cA + kstep, voffA); PG8_STAGE(PG8_SB(1, 1), cB + hstep + kstep, voffB);
        PG8_WAIT_V(6); PG8_BAR;
    } else {
        PG8_STAGE(PG8_SB(0, 0), cB, voffB); PG8_STAGE(PG8_SA(0, 0), cA, voffA); PG8_STAGE(PG8_SB(0, 1), cB + hstep, voffB); PG8_STAGE(PG8_SA(0, 1), cA + hstep, voffA);
        if (wr == 1) PG8_BAR;
        PG8_WAIT_V(4); PG8_BAR;
        PG8_STAGE(PG8_SB(1, 0), cB + kstep, voffB); PG8_STAGE(PG8_SA(1, 0), cA + kstep, voffA); PG8_STAGE(PG8_SB(1, 1), cB + hstep + kstep, voffB);
        PG8_WAIT_V(6); PG8_BAR;
    }
    for (;;) {
        const bool has_next = S.next(ui + 1, nxt);
        const char* nA = has_next ? (const char*)g.A + (size_t)nxt.pm * tstep : cA; const char* nB = has_next ? (const char*)g.Bt + (size_t)nxt.pn * tstep : cB;
        for (int t = 0; t < nt; t += 2) {
            const bool last = (t == nt - 2);
            const char* a1 = cA + (size_t)(t + 1) * kstep;
            const char* a2 = last ? nA : cA + (size_t)(t + 2) * kstep; const char* b2 = last ? nB : cB + (size_t)(t + 2) * kstep;
            const char* a3 = a2 + kstep; const char* b3 = b2 + kstep;
            if (last && has_next) S.a_ready(nxt);
            if constexpr (SP2) {
            PG8_LDB(B0, 0, 0); PG8_LDB(B1, 0, 1); PG8_SCHED; PG8_LDA(At, 0, 0); PG8_STAGE(PG8_SA(1, 1), a1 + hstep, voffA);
            PG8_WAIT_V(8); PG8_WAIT_L(0); PG8_BAR; PG8_MMA(0, 0, At, B0); PG8_MMA(0, 1, At, B1); PG8_BAR; PG8_SCHED;
            PG8_LDA(At, 0, 1); PG8_STAGE(PG8_SB(0, 0), b2, voffB); PG8_STAGE(PG8_SB(0, 1), b2 + hstep, voffB); PG8_STAGE(PG8_SA(0, 0), a2, voffA);
            PG8_WAIT_V(8); PG8_WAIT_L(0); PG8_BAR; PG8_MMA(1, 0, At, B0); PG8_MMA(1, 1, At, B1); PG8_BAR; PG8_SCHED;
            PG8_LDB(B0, 1, 0); PG8_LDB(B1, 1, 1); PG8_SCHED; PG8_LDA(At, 1, 0); PG8_STAGE(PG8_SA(0, 1), a2 + hstep, voffA);
            PG8_WAIT_V(8); PG8_WAIT_L(0); PG8_BAR; PG8_MMA(0, 0, At, B0); PG8_MMA(0, 1, At, B1); PG8_BAR; PG8_SCHED;
            PG8_LDA(At, 1, 1); PG8_STAGE(PG8_SB(1, 0), b3, voffB); PG8_STAGE(PG8_SB(1, 1), b3 + hstep, voffB); PG8_STAGE(PG8_SA(1, 0), a3, voffA);
            PG8_WAIT_V(8); PG8_WAIT_L(0); PG8_BAR; PG8_MMA(1, 0, At, B0); PG8_MMA(1, 1, At, B1); PG8_BAR; PG8_SCHED;
            } else {
            PG8_LDB(B0, 0, 0); PG8_SCHED; PG8_LDA(At, 0, 0); PG8_STAGE(PG8_SA(1, 1), a1 + hstep, voffA);
            PG8_WAIT_L(8); PG8_BAR; PG8_WAIT_L(0); PG8_MMA(0, 0, At, B0); PG8_BAR; PG8_SCHED;
            PG8_LDB(B1, 0, 1); PG8_STAGE(PG8_SB(0, 0), b2, voffB);
            PG8_BAR; PG8_WAIT_L(0); PG8_MMA(0, 1, At, B1); PG8_BAR;
            PG8_LDA(At, 0, 1); PG8_STAGE(PG8_SA(0, 0), a2, voffA);
            PG8_BAR; PG8_WAIT_L(0); PG8_MMA(1, 0, At, B0); PG8_BAR; PG8_SCHED;
            PG8_STAGE(PG8_SB(0, 1), b2 + hstep, voffB);
            PG8_WAIT_V(6); PG8_BAR; PG8_MMA(1, 1, At, B1); PG8_BAR;
            PG8_LDB(B0, 1, 0); PG8_SCHED; PG8_LDA(At, 1, 0); PG8_STAGE(PG8_SA(0, 1), a2 + hstep, voffA);
            PG8_WAIT_L(8); PG8_BAR; PG8_WAIT_L(0); PG8_MMA(0, 0, At, B0); PG8_BAR; PG8_SCHED;
            PG8_LDB(B1, 1, 1); PG8_STAGE(PG8_SB(1, 0), b3, voffB);
            PG8_BAR; PG8_WAIT_L(0); PG8_MMA(0, 1, At, B1); PG8_BAR;
            PG8_LDA(At, 1, 1); PG8_STAGE(PG8_SA(1, 0), a3, voffA);
            PG8_BAR; PG8_WAIT_L(0); PG8_MMA(1, 0, At, B0); PG8_BAR; PG8_SCHED;
            PG8_STAGE(PG8_SB(1, 1), b3 + hstep, voffB);
            PG8_WAIT_V(6); PG8_BAR; PG8_MMA(1, 1, At, B1); PG8_BAR;
            }
        }
        if constexpr (ALIGN_EPI) { if (wr == 0) PG8_BAR; }
        if constexpr (!Epi::AFTER_DRAIN) { E(acc, cur, wr, wc, fr, fq); S.done(cur); }
        if (!has_next) break;
#pragma unroll
        for (int a = 0; a < 2; ++a)
#pragma unroll
            for (int b = 0; b < 2; ++b)
#pragma unroll
                for (int m = 0; m < 4; ++m)
#pragma unroll
                    for (int n = 0; n < 2; ++n) acc[a][b][m][n] = (f32x4){0.f, 0.f, 0.f, 0.f};
        cur = nxt; cA = nA; cB = nB; ++ui;
        if constexpr (ALIGN_EPI) { if (wr == 1) PG8_BAR; }
    }
    PG8_WAIT_V(0);
    if constexpr (!ALIGN_EPI) { if (wr == 0) PG8_BAR; }
    PG8_BAR;
    if constexpr (Epi::AFTER_DRAIN) { E.fused(acc, cur, wr, wc, fr, fq, lds, wid, lane); S.done(cur); }
#undef PG8_SA
#undef PG8_SB
#undef PG8_STAGE
#undef PG8_LDA
#undef PG8_LDB
#undef PG8_MMA
#undef PG8_WAIT_V
#undef PG8_WAIT_L
#undef PG8_BAR
#undef PG8_SCHED
}
}
constexpr int S_ = 8192, D_ = 2048, DIN = 12288, DEPTH = 4;
constexpr size_t MiB = 1u << 20;
constexpr size_t WS_CTL = 3 * MiB, CTL_BYTES = 65536;
constexpr size_t WS_MOD = 0, WS_ROPE = 1 * MiB, WS_WIN = 4 * MiB, WS_WOUT = 196 * MiB, WS_WO = 228 * MiB, WS_H = 260 * MiB, WS_Q = 292 * MiB, WS_K = 308 * MiB, WS_V = 324 * MiB,
                 WS_VG = 340 * MiB, WS_GG = 356 * MiB, WS_ZB = 372 * MiB, WS_R = 388 * MiB, WS_SB = 420 * MiB, WS_YCAT = 452 * MiB, WS_MG = 484 * MiB, WS_X = 516 * MiB, WS_T = 580 * MiB, WS_END = 644 * MiB;
constexpr int LDS_BYTES = 147456;
#define LAS __attribute__((address_space(3)))
typedef unsigned short bf16;
typedef unsigned v4u __attribute__((ext_vector_type(4)));
typedef unsigned v2u __attribute__((ext_vector_type(2)));
typedef float f32x4 __attribute__((ext_vector_type(4)));
typedef float f32x16 __attribute__((ext_vector_type(16)));
typedef short bf16x8 __attribute__((ext_vector_type(8)));
typedef short s16x4 __attribute__((ext_vector_type(4)));
using pg8::cvt_pk_bf16; using pg8::bf_lo; using pg8::bf_hi; using pg8::fexp2; using pg8::frcp; using pg8::L2E;

struct Args { const float* in[17]; float* out; unsigned char* ws; int ph_lo, ph_hi; };

__device__ __forceinline__ float wave_sum(float v) {
    v += pg8::swz_xor<1>(v); v += pg8::swz_xor<2>(v); v += pg8::swz_xor<4>(v); v += pg8::swz_xor<8>(v); v += pg8::swz_xor<16>(v);
    return pg8::sum_x32(v);
}
__device__ __forceinline__ int map_in(int n0) {
    if (n0 < 4096) { const int seg = n0 >> 10, ch = n0 & 1023; const int tile = ((seg & 1) ? 8 : 0) + (ch >> 7); return tile * 256 + ((seg >> 1) ? 128 : 0) + (ch & 127); }
    if (n0 < 6144) { const int isk = n0 >= 5120, e = n0 - (isk ? 5120 : 4096), g = e >> 6, d = e & 63; return (16 + 4 * isk + (g >> 2)) * 256 + 128 * (d >> 5) + 32 * (g & 3) + (d & 31); }
    if (n0 < 8192) return n0;
    { const int isb = n0 >= 10240, j = n0 - (isb ? 10240 : 8192); return (32 + (j >> 7)) * 256 + 128 * isb + (j & 127); }
}
__device__ __forceinline__ void transpose_item(const float* W, int N, bf16* WT, int ldd, int koff, int k0, int n0, int drow0, LAS float* scr, int lane) {
    {
        f32x4 v[8]; const float* src = W + (size_t)(k0 + (lane >> 3)) * N + n0 + 4 * (lane & 7);
#pragma unroll
        for (int i = 0; i < 8; ++i) v[i] = __builtin_nontemporal_load((const f32x4*)(src + (size_t)(8 * i) * N));
#pragma unroll
        for (int i = 0; i < 8; ++i) { LAS float* d = scr + (8 * i + (lane >> 3)) * 33 + 4 * (lane & 7); d[0] = v[i].x; d[1] = v[i].y; d[2] = v[i].z; d[3] = v[i].w; }
    }
    asm volatile("s_waitcnt lgkmcnt(0)" ::: "memory");
    const int c = lane & 7;
#pragma unroll
    for (int j = 0; j < 4; ++j) { const int n = (lane >> 3) + 8 * j; const LAS float* s = scr + (8 * c) * 33 + n;
        v4u o; o.x = cvt_pk_bf16(s[0 * 33], s[1 * 33]); o.y = cvt_pk_bf16(s[2 * 33], s[3 * 33]); o.z = cvt_pk_bf16(s[4 * 33], s[5 * 33]); o.w = cvt_pk_bf16(s[6 * 33], s[7 * 33]);
        *(v4u*)(WT + (size_t)(drow0 + n) * ldd + koff + k0 + 8 * c) = o; }
    asm volatile("s_waitcnt lgkmcnt(0)" ::: "memory");
}
__device__ __forceinline__ void prologue(const Args& a, LAS unsigned char* lds, int tid, int lane, int wave) {
    unsigned char* ws = a.ws;
    if (blockIdx.x < 192 || gridDim.x < 192) {
        LAS float* cact = (LAS float*)lds; LAS float* red = (LAS float*)(lds + 8192);
        for (int i = tid; i < D_; i += 512) { const float v = a.in[1][i]; cact[i] = pg8::silu_f(v); }
        __syncthreads();
        for (int cgi = blockIdx.x; cgi < 192; cgi += gridDim.x) {
            const int l = cgi / 48, col0 = (cgi % 48) * 128 + 2 * lane;
            const float* w = a.in[2] + (size_t)l * D_ * 6144 + col0; float s0 = 0.f, s1 = 0.f;
#pragma unroll 8
            for (int k = wave * 256; k < wave * 256 + 256; ++k) { const float2 v = *(const float2*)(w + (size_t)k * 6144); const float cv = cact[k]; s0 += cv * v.x; s1 += cv * v.y; }
            red[wave * 128 + 2 * lane] = s0; red[wave * 128 + 2 * lane + 1] = s1;
            __syncthreads();
            if (tid < 128) { float s = a.in[3][l * 6144 + (cgi % 48) * 128 + tid];
#pragma unroll
                for (int w8 = 0; w8 < 8; ++w8) s += red[w8 * 128 + tid];
                ((float*)(ws + WS_MOD))[l * 6144 + (cgi % 48) * 128 + tid] = s; }
            __syncthreads();
        }
    }
    for (int e = blockIdx.x * 512 + tid; e < S_ * 32; e += gridDim.x * 512) {
        const int pos = e >> 5, i = e & 31; const float inv = exp2f(-(float)i * (13.287712379549449f / 32.0f)); const float ang = (float)pos * inv;
        const double rev = (double)ang * 0.15915494309189535; const float fr = (float)(rev - floor(rev));
        ((float2*)(ws + WS_ROPE))[e] = make_float2(__builtin_amdgcn_cosf(fr), __builtin_amdgcn_sinf(fr));
    }
    LAS float* scr = (LAS float*)(lds + wave * 16384);
    const int gw = blockIdx.x * 8 + wave, NGW = gridDim.x * 8;
    constexpr int I_IN = 32 * 384, I_C = 16 * 64, I_A = 16 * 64, I_O = 32 * 64, I_L = I_IN + I_C + I_A + I_O;
    for (int it = gw; it < DEPTH * I_L; it += NGW) {
        const int l = it / I_L; int r = it % I_L;
        if (r < I_IN) { const int kb = r / 384, nb = r % 384; transpose_item(a.in[5] + (size_t)l * D_ * DIN, DIN, (bf16*)(ws + WS_WIN) + (size_t)l * DIN * D_, D_, 0, 64 * kb, 32 * nb, map_in(32 * nb), scr, lane); continue; } r -= I_IN;
        if (r < I_C) { const int kb = r / 64, nb = r % 64; transpose_item(a.in[7] + (size_t)l * 1024 * D_, D_, (bf16*)(ws + WS_WOUT) + (size_t)l * D_ * D_, 1024, 0, 64 * kb, 32 * nb, 32 * nb, scr, lane); continue; } r -= I_C;
        if (r < I_A) { const int kb = r / 64, nb = r % 64; transpose_item(a.in[15] + (size_t)l * 1024 * D_, D_, (bf16*)(ws + WS_WOUT) + (size_t)l * D_ * D_ + (size_t)D_ * 1024, 1024, 0, 64 * kb, 32 * nb, 32 * nb, scr, lane); continue; } r -= I_A;
        { const int kb = r / 64, nb = r % 64; transpose_item(a.in[16] + (size_t)l * D_ * D_, D_, (bf16*)(ws + WS_WO) + (size_t)l * D_ * D_, D_, 0, 64 * kb, 32 * nb, 32 * nb, scr, lane); }
    }
}
__device__ __forceinline__ void norm_phase(const float* x, const float* g, const float* mod, bf16* H, int lane, int wave) {
    const int gw = blockIdx.x * 8 + wave, NGW = gridDim.x * 8;
    for (int row = gw; row < S_; row += 2 * NGW) {
        const int row2 = row + NGW; const bool has2 = row2 < S_;
        const f32x4* xr = (const f32x4*)(x + (size_t)row * D_) + lane; const f32x4* xr2 = (const f32x4*)(x + (size_t)(has2 ? row2 : row) * D_) + lane;
        f32x4 v[8], u[8]; float s = 0.f, s2 = 0.f;
#pragma unroll
        for (int j = 0; j < 8; ++j) { v[j] = xr[64 * j]; u[j] = xr2[64 * j]; }
#pragma unroll
        for (int j = 0; j < 8; ++j) { s += (v[j].x * v[j].x + v[j].y * v[j].y) + (v[j].z * v[j].z + v[j].w * v[j].w); s2 += (u[j].x * u[j].x + u[j].y * u[j].y) + (u[j].z * u[j].z + u[j].w * u[j].w); }
        const float rinv = __builtin_amdgcn_rsqf(wave_sum(s) * (1.0f / D_) + 1e-6f), rinv2 = __builtin_amdgcn_rsqf(wave_sum(s2) * (1.0f / D_) + 1e-6f);
        v2u* o8 = (v2u*)(H + (size_t)row * D_) + lane; v2u* o82 = (v2u*)(H + (size_t)row2 * D_) + lane;
#pragma unroll
        for (int j = 0; j < 8; ++j) { const int col = 4 * lane + 256 * j; const f32x4 gg = *(const f32x4*)(g + col), sh = *(const f32x4*)(mod + col), sc = *(const f32x4*)(mod + 2048 + col);
            const f32x4 gs = gg * (sc + 1.0f);
            const f32x4 y = v[j] * rinv * gs + sh; v2u w; w.x = cvt_pk_bf16(y.x, y.y); w.y = cvt_pk_bf16(y.z, y.w); o8[64 * j] = w;
            if (has2) { const f32x4 y2 = u[j] * rinv2 * gs + sh; v2u w2; w2.x = cvt_pk_bf16(y2.x, y2.y); w2.y = cvt_pk_bf16(y2.z, y2.w); o82[64 * j] = w2; } }
    }
}
__device__ __forceinline__ void conv_phase(const bf16* VG, const bf16* GG, const float* cw, bf16* YCAT, int tid) {
    for (int item = blockIdx.x * 512 + tid; item < 1024 * 128; item += gridDim.x * 512) {
        const int cgp = item & 127, rg = item >> 7, ch = cgp * 8, t0 = rg * 8;
        float w0[8], w1[8], w2[8], v0[8], v1[8];
#pragma unroll
        for (int j = 0; j < 8; ++j) { w0[j] = cw[ch + j]; w1[j] = cw[1024 + ch + j]; w2[j] = cw[2048 + ch + j]; v0[j] = 0.f; v1[j] = 0.f; }
        if (t0 > 0) { const v4u a = *(const v4u*)(VG + (size_t)(t0 - 2) * 1024 + ch), b = *(const v4u*)(VG + (size_t)(t0 - 1) * 1024 + ch);
            v0[0] = bf_lo(a.x); v0[1] = bf_hi(a.x); v0[2] = bf_lo(a.y); v0[3] = bf_hi(a.y); v0[4] = bf_lo(a.z); v0[5] = bf_hi(a.z); v0[6] = bf_lo(a.w); v0[7] = bf_hi(a.w);
            v1[0] = bf_lo(b.x); v1[1] = bf_hi(b.x); v1[2] = bf_lo(b.y); v1[3] = bf_hi(b.y); v1[4] = bf_lo(b.z); v1[5] = bf_hi(b.z); v1[6] = bf_lo(b.w); v1[7] = bf_hi(b.w); }
#pragma unroll
        for (int i = 0; i < 8; ++i) { const v4u a = *(const v4u*)(VG + (size_t)(t0 + i) * 1024 + ch), gq = *(const v4u*)(GG + (size_t)(t0 + i) * 1024 + ch);
            float v2[8], gv[8], y[8];
            v2[0] = bf_lo(a.x); v2[1] = bf_hi(a.x); v2[2] = bf_lo(a.y); v2[3] = bf_hi(a.y); v2[4] = bf_lo(a.z); v2[5] = bf_hi(a.z); v2[6] = bf_lo(a.w); v2[7] = bf_hi(a.w);
            gv[0] = bf_lo(gq.x); gv[1] = bf_hi(gq.x); gv[2] = bf_lo(gq.y); gv[3] = bf_hi(gq.y); gv[4] = bf_lo(gq.z); gv[5] = bf_hi(gq.z); gv[6] = bf_lo(gq.w); gv[7] = bf_hi(gq.w);
#pragma unroll
            for (int j = 0; j < 8; ++j) { y[j] = gv[j] * (w0[j] * v0[j] + w1[j] * v1[j] + w2[j] * v2[j]); v0[j] = v1[j]; v1[j] = v2[j]; }
            v4u o; o.x = cvt_pk_bf16(y[0], y[1]); o.y = cvt_pk_bf16(y[2], y[3]); o.z = cvt_pk_bf16(y[4], y[5]); o.w = cvt_pk_bf16(y[6], y[7]);
            *(v4u*)(YCAT + (size_t)(t0 + i) * 1024 + ch) = o; }
    }
}
namespace att {
constexpr int KS = 144, VS = 320, KT_BYTES = 2 * 64 * KS, VT_BYTES = 64 * VS, BUF = KT_BYTES + VT_BYTES;
constexpr float THR = 24.0f;
__device__ __forceinline__ int crow(int r, int hi) { return (r & 3) + 8 * (r >> 2) + 4 * hi; }
__device__ __forceinline__ s16x4 vtr(const LAS unsigned char* p) { return __builtin_bit_cast(s16x4, __builtin_amdgcn_ds_read_tr16_b64_v4i16((LAS s16x4*)p)); }
#define ATT_SB() __builtin_amdgcn_sched_barrier(0)
__device__ __forceinline__ bf16x8 pack_slab(const f32x16& p, int s2) { v4u u_; u_.x = cvt_pk_bf16(p[8 * s2], p[8 * s2 + 1]); u_.y = cvt_pk_bf16(p[8 * s2 + 2], p[8 * s2 + 3]); u_.z = cvt_pk_bf16(p[8 * s2 + 4], p[8 * s2 + 5]); u_.w = cvt_pk_bf16(p[8 * s2 + 6], p[8 * s2 + 7]); return __builtin_bit_cast(bf16x8, u_); }
template <bool CHECK> __device__ __forceinline__ void unit(LAS unsigned char* lds, const bf16* Q, const bf16* K, const bf16* V, const bf16* ZB, bf16* YCAT, const float* subg, float lam, float oscale, int h, int qb, int tid_in, int lane_in, int w) {
    int lane = (int)__builtin_amdgcn_mbcnt_hi(~0u, __builtin_amdgcn_mbcnt_lo(~0u, 0u)); asm volatile("" : "+v"(lane)); const int tid = w * 64 + lane;
    const int c = w >> 2, wq = w & 3; int r32 = lane & 31, hi = lane >> 5;
    const int q0 = 128 * qb + 32 * wq, NT = 2 * qb + 2, ntw = (q0 >> 6) + 1;
    LAS unsigned char* qlds = lds + 2 * KT_BYTES + 2 * VT_BYTES + w * 4096 + lane * 16;
    { const bf16* qp = Q + (size_t)(q0 + r32) * 1024 + 128 * h + 64 * c + 8 * hi;
#pragma unroll
      for (int ks = 0; ks < 4; ++ks) *(LAS bf16x8*)(qlds + ks * 1024) = *(const bf16x8*)(qp + 16 * ks); }
#define ATT_Q(ks) (*(const LAS bf16x8*)(qlds + (ks) * 1024))
    const int key_s = tid >> 4, ch_s = tid & 15;
    const unsigned goff = (unsigned)(key_s * 1024 + ch_s * 8) * 2u;
    const char* kgb = (const char*)(K + 128 * h); const char* vgb = (const char*)(V + 128 * h);
    const int kdst = (ch_s >> 3) * 64 * KS + key_s * KS + (ch_s & 7) * 16, vdst = 2 * KT_BYTES + key_s * VS + ch_s * 16;
    v4u kr[2], vr[2];
#define ATT_LOADK(t) do { _Pragma("unroll") for (int i_ = 0; i_ < 2; ++i_) kr[i_] = *(const v4u*)(kgb + (size_t)(64 * (t) + 32 * i_) * 2048 + goff); } while (0)
#define ATT_LOADV(t) do { _Pragma("unroll") for (int i_ = 0; i_ < 2; ++i_) vr[i_] = *(const v4u*)(vgb + (size_t)(64 * (t) + 32 * i_) * 2048 + goff); } while (0)
#define ATT_STOREK(b) do { _Pragma("unroll") for (int i_ = 0; i_ < 2; ++i_) *(LAS v4u*)(lds + (b) * KT_BYTES + kdst + 32 * i_ * KS) = kr[i_]; } while (0)
#define ATT_STOREV(b) do { _Pragma("unroll") for (int i_ = 0; i_ < 2; ++i_) *(LAS v4u*)(lds + (b) * VT_BYTES + vdst + 32 * i_ * VS) = vr[i_]; } while (0)
    const int kfo = c * 64 * KS + r32 * KS + hi * 16;
    const int vfo = 2 * KT_BYTES + (4 * hi + ((lane & 15) >> 2)) * VS + (16 * ((lane >> 4) & 1) + 4 * (lane & 3)) * 2;
    ATT_LOADK(0); ATT_LOADV(0); ATT_STOREK(0); ATT_STOREV(0); ATT_LOADK(1); ATT_STOREK(1);
    f32x16 o[4];
#pragma unroll
    for (int b = 0; b < 4; ++b) o[b] = f32x16{};
    float mref = 0.f, l = 0.f; f32x16 negm = f32x16{}; asm volatile("" : "+v"(negm));
    f32x16 sa = f32x16{}, sb = f32x16{}, sc = f32x16{}, sd = f32x16{};
    __syncthreads();
    { const LAS unsigned char* kb = lds + kfo;
#pragma unroll
      for (int ks = 0; ks < 4; ++ks) { const bf16x8 a0 = *(const LAS bf16x8*)(kb + ks * 32), a1 = *(const LAS bf16x8*)(kb + 32 * KS + ks * 32);
          sa = __builtin_amdgcn_mfma_f32_32x32x16_bf16(a0, ATT_Q(ks), sa, 0, 0, 0); sb = __builtin_amdgcn_mfma_f32_32x32x16_bf16(a1, ATT_Q(ks), sb, 0, 0, 0); }
      float rm = fmaxf(sa[0], sb[0]);
#pragma unroll
      for (int r_ = 1; r_ < 16; ++r_) rm = fmaxf(rm, fmaxf(sa[r_], sb[r_]));
      rm = pg8::max_x32(rm);
      if (CHECK && __any(rm < -THR)) { mref = fminf(rm, 0.f);
#pragma unroll
          for (int r_ = 0; r_ < 16; ++r_) { sa[r_] -= mref; sb[r_] -= mref; negm[r_] = -mref; } } }
#define ATT_EXP8(P, s2) do { _Pragma("unroll") for (int r_ = 0; r_ < 8; ++r_) { P[8 * (s2) + r_] = fexp2(P[8 * (s2) + r_]); ls += P[8 * (s2) + r_]; } } while (0)
#define ATT_VRD(dst, s_) do { _Pragma("unroll") for (int b_ = 0; b_ < 4; ++b_) { const s16x4 lo_ = vtr(vb + (s_) * 16 * VS + b_ * 64), hh_ = vtr(vb + (s_) * 16 * VS + 8 * VS + b_ * 64); \
        dst[b_] = (bf16x8){lo_[0], lo_[1], lo_[2], lo_[3], hh_[0], hh_[1], hh_[2], hh_[3]}; } } while (0)
#define ATT_PV(vf, pw_) do { _Pragma("unroll") for (int b_ = 0; b_ < 4; ++b_) o[b_] = __builtin_amdgcn_mfma_f32_32x32x16_bf16(vf[b_], pw_, o[b_], 0, 0, 0); } while (0)
#define ATT_MAX3(a_, b_, c_) ({ float r__; asm("v_max3_f32 %0, %1, %2, %3" : "=v"(r__) : "v"(a_), "v"(b_), "v"(c_)); r__; })
#define ATT_ROWMAX(dst, X0, X1) do { float a__ = ATT_MAX3(X0[0], X0[1], X1[0]), b__ = ATT_MAX3(X0[2], X0[3], X1[1]); a__ = ATT_MAX3(a__, X1[2], X1[3]); \
        _Pragma("unroll") for (int r_ = 4; r_ < 16; r_ += 4) { a__ = ATT_MAX3(a__, X0[r_], X0[r_ + 1]); b__ = ATT_MAX3(b__, X0[r_ + 2], X0[r_ + 3]); a__ = ATT_MAX3(a__, X1[r_], X1[r_ + 1]); b__ = ATT_MAX3(b__, X1[r_ + 2], X1[r_ + 3]); } \
        dst = ATT_MAX3(a__, b__, b__); } while (0)
#define ATT_STEP(C0, C1, N0, N1, t) do { \
        __syncthreads(); \
        const LAS unsigned char* kb = lds + (((t) + 1) & 1) * KT_BYTES + kfo; const LAS unsigned char* vb = lds + ((t) & 1) * VT_BYTES + vfo; \
        if (CHECK) { float rm; ATT_ROWMAX(rm, C0, C1); \
          if (__any(rm > THR)) { rm = pg8::max_x32(rm); const float dl = fmaxf(rm, 0.f); mref += dl; const float al = fexp2(-dl); l *= al; \
              _Pragma("unroll") for (int r_ = 0; r_ < 16; ++r_) { C0[r_] -= dl; C1[r_] -= dl; negm[r_] = -mref; } \
              _Pragma("unroll") for (int b_ = 0; b_ < 4; ++b_) o[b_] *= al; } } \
        bf16x8 kf[4], vfa[4], qa, qb_; float ls = 0.f; bf16x8 pwa; \
        qa = ATT_Q(0); qb_ = ATT_Q(1); \
        _Pragma("unroll") for (int ks = 0; ks < 2; ++ks) { kf[2 * ks] = *(const LAS bf16x8*)(kb + ks * 32); kf[2 * ks + 1] = *(const LAS bf16x8*)(kb + 32 * KS + ks * 32); } \
        ATT_VRD(vfa, 0); ATT_SB(); ATT_EXP8(C0, 0); pwa = pack_slab(C0, 0); ATT_SB(); \
        if (CHECK) { N0 = __builtin_amdgcn_mfma_f32_32x32x16_bf16(kf[0], qa, negm, 0, 0, 0); N1 = __builtin_amdgcn_mfma_f32_32x32x16_bf16(kf[1], qa, negm, 0, 0, 0); } else { N0 = __builtin_amdgcn_mfma_f32_32x32x16_bf16(kf[0], qa, f32x16{}, 0, 0, 0); N1 = __builtin_amdgcn_mfma_f32_32x32x16_bf16(kf[1], qa, f32x16{}, 0, 0, 0); } \
        N0 = __builtin_amdgcn_mfma_f32_32x32x16_bf16(kf[2], qb_, N0, 0, 0, 0); N1 = __builtin_amdgcn_mfma_f32_32x32x16_bf16(kf[3], qb_, N1, 0, 0, 0); \
        qa = ATT_Q(2); qb_ = ATT_Q(3); \
        _Pragma("unroll") for (int ks = 0; ks < 2; ++ks) { kf[2 * ks] = *(const LAS bf16x8*)(kb + (ks + 2) * 32); kf[2 * ks + 1] = *(const LAS bf16x8*)(kb + 32 * KS + (ks + 2) * 32); } \
        ATT_PV(vfa, pwa); ATT_VRD(vfa, 1); ATT_EXP8(C0, 1); pwa = pack_slab(C0, 1); ATT_SB(); \
        N0 = __builtin_amdgcn_mfma_f32_32x32x16_bf16(kf[0], qa, N0, 0, 0, 0); N1 = __builtin_amdgcn_mfma_f32_32x32x16_bf16(kf[1], qa, N1, 0, 0, 0); \
        N0 = __builtin_amdgcn_mfma_f32_32x32x16_bf16(kf[2], qb_, N0, 0, 0, 0); N1 = __builtin_amdgcn_mfma_f32_32x32x16_bf16(kf[3], qb_, N1, 0, 0, 0); \
        ATT_SB(); if ((t) + 2 < NT) ATT_LOADK((t) + 2); \
        if ((t) + 1 < NT) ATT_LOADV((t) + 1); \
        ATT_PV(vfa, pwa); ATT_VRD(vfa, 2); ATT_EXP8(C1, 0); pwa = pack_slab(C1, 0); ATT_SB(); \
        ATT_PV(vfa, pwa); ATT_VRD(vfa, 3); ATT_EXP8(C1, 1); pwa = pack_slab(C1, 1); ATT_SB(); \
        ATT_PV(vfa, pwa); l += ls; \
        if ((t) + 1 >= ntw) { asm volatile("" ::: "memory"); _Pragma("unroll") for (int r_ = 0; r_ < 16; ++r_) { N0[r_] = -1e30f; N1[r_] = -1e30f; } } \
        if ((t) + 2 < NT) ATT_STOREK((t) & 1); \
        if ((t) + 1 < NT) ATT_STOREV(((t) + 1) & 1); \
    } while (0)
    for (int t = 0; t < NT; t += 2) { ATT_STEP(sa, sb, sc, sd, t); ATT_STEP(sc, sd, sa, sb, t + 1); }
#undef ATT_MAX3
#undef ATT_ROWMAX
#undef ATT_LOADK
#undef ATT_LOADV
#undef ATT_STOREK
#undef ATT_STOREV
#undef ATT_EXP8
#undef ATT_VRD
#undef ATT_PV
#undef ATT_STEP
    __syncthreads();
    l = pg8::sum_x32(l); const float inv = 1.0f / l;
    { lane = (int)__builtin_amdgcn_mbcnt_hi(~0u, __builtin_amdgcn_mbcnt_lo(~0u, 0u)); asm volatile("" : "+v"(lane)); r32 = lane & 31; hi = lane >> 5; }
    LAS float* ex = (LAS float*)lds + wq * 4096;
    if (c == 1) {
#pragma unroll
        for (int b = 0; b < 4; ++b)
#pragma unroll
            for (int r = 0; r < 16; ++r) ex[(32 * b + crow(r, hi)) * 32 + r32] = o[b][r] * inv;
    }
    __syncthreads();
    if (c == 0) {
        float ss = 0.f;
#pragma unroll
        for (int b = 0; b < 4; ++b)
#pragma unroll
            for (int r = 0; r < 16; ++r) { const float v = o[b][r] * inv - lam * ex[(32 * b + crow(r, hi)) * 32 + r32]; o[b][r] = v; ss += v * v; }
        ss = pg8::sum_x32(ss);
        const float rn = __builtin_amdgcn_rsqf(ss * (1.0f / 128.0f) + 1e-6f) * oscale;
        const int row = q0 + r32;
#pragma unroll
        for (int b = 0; b < 4; ++b)
#pragma unroll
            for (int g = 0; g < 4; ++g) { const int dv = 32 * b + 8 * g + 4 * hi;
                const v2u z = *(const v2u*)(ZB + (size_t)row * 1024 + 128 * h + dv); const f32x4 sg = *(const f32x4*)(subg + dv);
                v2u wv; wv.x = cvt_pk_bf16(o[b][4 * g] * rn * sg.x * bf_lo(z.x), o[b][4 * g + 1] * rn * sg.y * bf_hi(z.x)); wv.y = cvt_pk_bf16(o[b][4 * g + 2] * rn * sg.z * bf_lo(z.y), o[b][4 * g + 3] * rn * sg.w * bf_hi(z.y));
                *(v2u*)(YCAT + (size_t)S_ * 1024 + (size_t)row * 1024 + 128 * h + dv) = wv; }
    }
    __syncthreads();
}
}

#define XB_TMO      128
#define XB_XCNT(j)  (256  + 64 * (j))
#define XB_XSUB(j)  (1280 + 64 * (j))
#define XB_XGEN(j)  (2304 + 64 * (j))
#define XB_TOP      3328
#define XB_TOPGEN   3392
#define XCD_BAR_WORDS 3456
#define XB_SPIN_CAP (1u << 18)

__device__ __forceinline__ unsigned xb_ld(unsigned* p)              { return __hip_atomic_load(p, __ATOMIC_RELAXED, __HIP_MEMORY_SCOPE_AGENT); }
__device__ __forceinline__ unsigned xb_add(unsigned* p, unsigned v) { return __hip_atomic_fetch_add(p, v, __ATOMIC_RELAXED, __HIP_MEMORY_SCOPE_AGENT); }
__device__ __forceinline__ unsigned xb_xcc_id() { return (unsigned)__builtin_amdgcn_s_getreg((3 << 11) | 20) & 0xFu; }
#define XB_SPIN(cond, bar) do { unsigned _sp = 0; while (cond) { __builtin_amdgcn_s_sleep(1); \
    if ((++_sp & 255u) == 0u) { if (xb_ld(&(bar)[XB_TMO])) break; if (_sp > XB_SPIN_CAP) { atomicAdd(&(bar)[XB_TMO], 1u); break; } } } } while (0)

struct XcdBarrier {
    unsigned* bar; unsigned x;
    volatile LAS unsigned* st;
};

__device__ __forceinline__ XcdBarrier xcd_barrier_post(unsigned* bar, volatile LAS unsigned* st) {
    XcdBarrier b; b.bar = bar; b.x = xb_xcc_id(); b.st = st;
    if (threadIdx.x == 0) (void)xb_add(&bar[XB_XCNT(b.x)], 1u);
    return b;
}
__device__ __forceinline__ void xcd_barrier_complete(unsigned* bar, unsigned x, unsigned& nloc, unsigned& nx) {
    const unsigned G = gridDim.x * gridDim.y * gridDim.z;
    unsigned sum, cnt, mine, sp = 0u;
    for (;;) {
        sum = 0u; cnt = 0u; mine = 0u;
#pragma unroll
        for (unsigned j = 0; j < 16; ++j) { const unsigned c = xb_ld(&bar[XB_XCNT(j)]); sum += c; cnt += (c > 0u) ? 1u : 0u; mine = (j == x) ? c : mine; }
        if (sum == G) break;
        __builtin_amdgcn_s_sleep(1);
        if ((++sp & 255u) == 0u) { if (xb_ld(&bar[XB_TMO])) break; if (sp > XB_SPIN_CAP) { atomicAdd(&bar[XB_TMO], 1u); break; } }
    }
    nloc = mine > 0u ? mine : 1u; nx = cnt > 0u ? cnt : 1u;
}

__device__ __forceinline__ void xcd_barrier(const XcdBarrier& b) {
    asm volatile("s_waitcnt vmcnt(0)" ::: "memory");
    __syncthreads();
    if (threadIdx.x == 0) {
        unsigned* bar = b.bar;
        __builtin_amdgcn_s_waitcnt(0);
        unsigned nloc = b.st[0], nx = b.st[1];
        if (nloc == 0u) { xcd_barrier_complete(bar, b.x, nloc, nx); b.st[0] = nloc; b.st[1] = nx; }
        const unsigned old = xb_add(&bar[XB_XSUB(b.x)], 1u);
        const unsigned gen = old / nloc;
        if (old + 1u == (gen + 1u) * nloc) {
            __builtin_amdgcn_fence(__ATOMIC_RELEASE, "agent");
            asm volatile("s_waitcnt vmcnt(0)" ::: "memory");
            const unsigned og = xb_add(&bar[XB_TOP], 1u);
            const unsigned tg = og / nx;
            if (og + 1u == (tg + 1u) * nx) xb_add(&bar[XB_TOPGEN], 1u);
            else XB_SPIN(xb_ld(&bar[XB_TOPGEN]) == tg, bar);
            __builtin_amdgcn_fence(__ATOMIC_ACQUIRE, "agent");
            xb_add(&bar[XB_XGEN(b.x)], 1u);
            asm volatile("s_waitcnt vmcnt(0)" ::: "memory");
        } else {
            XB_SPIN(xb_ld(&bar[XB_XGEN(b.x)]) == gen, bar);
            __builtin_amdgcn_fence(__ATOMIC_ACQUIRE, "agent");
            asm volatile("s_waitcnt vmcnt(0)" ::: "memory");
        }
    }
    __syncthreads();
}

__global__ void __launch_bounds__(512, 2) mega_fwd(Args args) {
    extern __shared__ __attribute__((aligned(16))) unsigned char lds_raw[];
    LAS unsigned char* lds = (LAS unsigned char*)lds_raw;
    int tid = threadIdx.x, lane = tid & 63, wave = __builtin_amdgcn_readfirstlane(tid >> 6);
#define RELAUNDER() do { lane = (int)__builtin_amdgcn_mbcnt_hi(~0u, __builtin_amdgcn_mbcnt_lo(~0u, 0u)); asm volatile("" : "+v"(lane)); tid = wave * 64 + lane; } while (0)
    unsigned char* ws = args.ws;
    const int lo = args.ph_lo, hi = args.ph_hi;
    volatile LAS unsigned* bst = (volatile LAS unsigned*)(lds + 131072 + 32);
    if (tid < 2) bst[tid] = 0u;
    __syncthreads();
    XcdBarrier bar = xcd_barrier_post((unsigned*)(ws + WS_CTL), bst);
#define IN(k) (lo <= (k) && (k) < hi)
#define SEAM(k) do { if (IN(k) && IN((k) + 1)) { if ((k) == 0) cg::this_grid().sync(); else xcd_barrier(bar); } } while (0)
    if (IN(0)) {
#ifndef NO_PRO
 for (int rep_ = 0; rep_ < REP_PRO; ++rep_) { prologue(args, lds, tid, lane, wave); __syncthreads(); }
#endif
 }
    SEAM(0);
    bf16* Hb = (bf16*)(ws + WS_H); bf16* Qb = (bf16*)(ws + WS_Q); bf16* Kb = (bf16*)(ws + WS_K); bf16* Vb = (bf16*)(ws + WS_V); bf16* VG = (bf16*)(ws + WS_VG); bf16* GG = (bf16*)(ws + WS_GG);
    bf16* ZB = (bf16*)(ws + WS_ZB); bf16* Rb = (bf16*)(ws + WS_R); bf16* SBb = (bf16*)(ws + WS_SB); bf16* YC = (bf16*)(ws + WS_YCAT); bf16* MG = (bf16*)(ws + WS_MG); float* XW = (float*)(ws + WS_X);
    for (int l = 0; l < DEPTH; ++l) {
        const int pb = 1 + 5 * l;
        const float* mod = (const float*)(ws + WS_MOD) + l * 6144;
        const float* xin = (l == 0) ? args.in[0] : XW; float* xout = (l == DEPTH - 1) ? args.out : XW;
#ifndef NO_NORM
        RELAUNDER();
        if (IN(pb)) for (int rep_ = 0; rep_ < REP_NORM; ++rep_) norm_phase(xin, args.in[4] + l * D_, mod, Hb, lane, wave);
#endif
        SEAM(pb);
        if (IN(pb + 1)) {
            pg8::Gemm g{Hb, (const bf16*)(ws + WS_WIN) + (size_t)l * DIN * D_, S_, DIN, D_}; pg8::StaticOrder S; S.init(S_, DIN, gridDim.x, (int)blockIdx.x);
            pg8::InProjEpi E{Qb, Kb, Vb, VG, GG, ZB, Rb, SBb, args.in[8] + l * 64, args.in[9] + l * 64, (const float*)(ws + WS_ROPE), 0.125f * L2E};
#ifndef NO_INPROJ
            for (int rep_ = 0; rep_ < REP_INPROJ; ++rep_) pg8::gemm_phase<pg8::InProjEpi, pg8::StaticOrder, true, true>(lds, g, S, E, wave);
#endif
        }
        SEAM(pb + 1);
        if (IN(pb + 2)) { RELAUNDER();
#ifndef NO_CONV
            conv_phase(VG, GG, args.in[6] + l * 3 * 1024, YC, tid);
#endif
            const float s1 = wave_sum(args.in[10][l * 64 + lane] * args.in[11][l * 64 + lane]), s2 = wave_sum(args.in[12][l * 64 + lane] * args.in[13][l * 64 + lane]);
            const float linit = 0.8f - 0.6f * expf(-0.3f * (float)l); const float lam = expf(s1) - expf(s2) + linit;
            float gqm = fabsf(args.in[8][l * 64 + lane]), gkm = fabsf(args.in[9][l * 64 + lane]);
            gqm = fmaxf(gqm, pg8::swz_xor<1>(gqm)); gqm = fmaxf(gqm, pg8::swz_xor<2>(gqm)); gqm = fmaxf(gqm, pg8::swz_xor<4>(gqm)); gqm = fmaxf(gqm, pg8::swz_xor<8>(gqm)); gqm = fmaxf(gqm, pg8::swz_xor<16>(gqm));
            gkm = fmaxf(gkm, pg8::swz_xor<1>(gkm)); gkm = fmaxf(gkm, pg8::swz_xor<2>(gkm)); gkm = fmaxf(gkm, pg8::swz_xor<4>(gkm)); gkm = fmaxf(gkm, pg8::swz_xor<8>(gkm)); gkm = fmaxf(gkm, pg8::swz_xor<16>(gkm));
            gqm = pg8::max_x32(gqm); gkm = pg8::max_x32(gkm);
            const bool safe = __builtin_amdgcn_readfirstlane(__float_as_int(8.0f * L2E * gqm * gkm * 1.0625f)) < __float_as_int(att::THR) && !(gqm != gqm) && !(gkm != gkm);
#ifndef NO_ATT
            for (int rep_ = 0; rep_ < REP_ATT; ++rep_)
            for (int pr = blockIdx.x; pr < 256; pr += gridDim.x) { const int h = pr & 7, pi = pr >> 3;
                if (safe) { att::unit<false>(lds, Qb, Kb, Vb, ZB, YC, args.in[14] + l * 128, lam, 1.0f - linit, h, 63 - pi, tid, lane, wave);
                            att::unit<false>(lds, Qb, Kb, Vb, ZB, YC, args.in[14] + l * 128, lam, 1.0f - linit, h, pi, tid, lane, wave); }
                else { att::unit<true>(lds, Qb, Kb, Vb, ZB, YC, args.in[14] + l * 128, lam, 1.0f - linit, h, 63 - pi, tid, lane, wave);
                       att::unit<true>(lds, Qb, Kb, Vb, ZB, YC, args.in[14] + l * 128, lam, 1.0f - linit, h, pi, tid, lane, wave); } }
#endif
        }
        SEAM(pb + 2);
        if (IN(pb + 3)) {
            pg8::StaticOrder S; S.init(S_, D_, gridDim.x, (int)blockIdx.x); bf16* Tb = (bf16*)(ws + WS_T);
#ifndef NO_MERGE
            for (int rep_ = 0; rep_ < REP_MERGE; ++rep_) {
            { pg8::Gemm g{YC, (const bf16*)(ws + WS_WOUT) + (size_t)l * D_ * D_, S_, D_, 1024}; pg8::Merge1Epi E{Rb, Tb};
              pg8::gemm_phase<pg8::Merge1Epi, pg8::StaticOrder, true, true>(lds, g, S, E, wave); }
            { pg8::Gemm g{YC + (size_t)S_ * 1024, (const bf16*)(ws + WS_WOUT) + (size_t)l * D_ * D_ + (size_t)D_ * 1024, S_, D_, 1024}; pg8::Merge2Epi E{SBb, Tb, MG};
              pg8::gemm_phase<pg8::Merge2Epi, pg8::StaticOrder, true, true>(lds, g, S, E, wave); }
            }
#endif
        }
        SEAM(pb + 3);
        if (IN(pb + 4)) {
            pg8::Gemm g{MG, (const bf16*)(ws + WS_WO) + (size_t)l * D_ * D_, S_, D_, D_}; pg8::StaticOrder S; S.init(S_, D_, gridDim.x, (int)blockIdx.x);
            pg8::ResEpi E{xin, xout, mod + 4096};
#ifndef NO_RES
            pg8::gemm_phase<pg8::ResEpi, pg8::StaticOrder, true, true>(lds, g, S, E, wave);
#endif
        }
        SEAM(pb + 4);
    }
#undef IN
#undef SEAM
}
constexpr int N_PHASES = 1 + 5 * DEPTH;

extern "C" void kernel_launch(void* const* d_in, const int* in_sizes, int n_in, void* d_out, int out_size, void* d_ws, size_t ws_size, hipStream_t stream) {
    static int grid = 0;
    if (grid == 0) {
        if (n_in != 17 || out_size != S_ * D_ || ws_size < WS_END) { fprintf(stderr, "kernel_launch: unexpected shapes (n_in %d out %d ws %zu)\n", n_in, out_size, ws_size); grid = -1; return; }
        int dev = 0, cus = 0, per_cu = 0;
        hipGetDevice(&dev); hipDeviceGetAttribute(&cus, hipDeviceAttributeMultiprocessorCount, dev);
        if (hipFuncSetAttribute((const void*)mega_fwd, hipFuncAttributeMaxDynamicSharedMemorySize, LDS_BYTES) != hipSuccess) { fprintf(stderr, "kernel_launch: hipFuncSetAttribute failed\n"); grid = -1; return; }
        if (hipOccupancyMaxActiveBlocksPerMultiprocessor(&per_cu, (const void*)mega_fwd, 512, LDS_BYTES) != hipSuccess || per_cu < 1) { fprintf(stderr, "kernel_launch: occupancy query says %d\n", per_cu); per_cu = 1; }
        (void)hipGetLastError();
        grid = cus * 1;
        if (grid > 256) grid = 256;
    }
    if (grid < 0) return;
    if (hipMemsetAsync((char*)d_ws + WS_CTL, 0, CTL_BYTES, stream) != hipSuccess) { fprintf(stderr, "kernel_launch: memset failed\n"); return; }
    Args a{};
    for (int i = 0; i < 17; ++i) a.in[i] = (const float*)d_in[i];
    a.out = (float*)d_out; a.ws = (unsigned char*)d_ws;
#if MK_MULTI
    for (int p = 0; p < N_PHASES; ++p) { a.ph_lo = p; a.ph_hi = p + 1; hipLaunchKernelGGL(mega_fwd, dim3(grid), dim3(512), LDS_BYTES, stream, a); }
#else
    a.ph_lo = 0; a.ph_hi = N_PHASES;
    void* kargs[] = {&a};
    hipError_t e = hipLaunchCooperativeKernel((const void*)mega_fwd, dim3(grid), dim3(512), kargs, LDS_BYTES, stream);
    if (e != hipSuccess) fprintf(stderr, "cooperative launch failed: %s (grid %d)\n", hipGetErrorString(e), grid);
#endif
}
```
